# Optimizing an MI355X kernel written in HIP

```python
import jax, jax.numpy as jnp
from jax import lax
import numpy as np

D_MODEL = 2048
BATCH = 4
SEQ = 2048
DEPTH = 1
DEC_BATCH = 8
DEC_SEQ = 8
PAST_LEN = 16384
PAGE_SIZE = 128

N_HEADS = D_MODEL // 128
ATTN_WIDTH = D_MODEL // 2
HEAD_DIM = ATTN_WIDTH // N_HEADS
POOL_WIDTH = D_MODEL // 2
POOL_WINDOWS = (2, 4, 8, 16)
N_POOL_GROUPS = len(POOL_WINDOWS)
POOL_GROUP = POOL_WIDTH // N_POOL_GROUPS
POOL_BUF = max(POOL_WINDOWS) - 1
Q_BLOCK = 128
EPS = 1e-6
NEG_INF = -1e30
IN_SIZES = (POOL_WIDTH, POOL_WIDTH, ATTN_WIDTH, ATTN_WIDTH, ATTN_WIDTH, ATTN_WIDTH, N_HEADS, D_MODEL, D_MODEL)
IN_COLS = sum(IN_SIZES)

kernel_name = "hybrid_pool_forgetting_attn_step"


def rms_norm(x, g):
    xf = x.astype(jnp.float32)
    r = lax.rsqrt(jnp.mean(xf * xf, axis=-1, keepdims=True) + EPS)
    return (xf * r * g.astype(jnp.float32)).astype(x.dtype)


def pool_mixer(u, buf, pos0, w_pool_map, pool_scale):
    B, L, _ = u.shape
    z = jnp.concatenate([buf.astype(u.dtype), u], axis=1).astype(jnp.float32)
    c = jnp.concatenate([jnp.zeros((B, 1, POOL_WIDTH), jnp.float32), jnp.cumsum(z, axis=1)], axis=1)
    pos = pos0 + jnp.arange(L)
    means = []
    for g, w in enumerate(POOL_WINDOWS):
        sl = slice(g * POOL_GROUP, (g + 1) * POOL_GROUP)
        end = c[:, POOL_BUF + 1:POOL_BUF + 1 + L, sl]
        start = c[:, POOL_BUF + 1 - w:POOL_BUF + 1 - w + L, sl]
        cnt = jnp.minimum(pos + 1, w).astype(jnp.float32)[None, :, None]
        means.append((end - start) / cnt)
    d = (jnp.concatenate(means, axis=-1) - u.astype(jnp.float32)).astype(u.dtype)
    d = d.reshape(B, L, N_POOL_GROUPS, POOL_GROUP)
    mixed = jnp.einsum('blgc,gcd->blgd', d, w_pool_map).reshape(B, L, POOL_WIDTH)
    return mixed * pool_scale


def forgetting_attention(q, k, v, qb, kb, q_pos, k_pos):
    B, Lq, H, Dh = q.shape
    blk = min(Q_BLOCK, Lq)
    nb = -(-Lq // blk)
    pad = nb * blk - Lq
    qp = jnp.pad(q, ((0, 0), (0, pad), (0, 0), (0, 0)))
    qbp = jnp.pad(qb, ((0, 0), (0, pad), (0, 0)))
    posp = jnp.pad(q_pos, (0, pad), mode='edge')
    qs = qp.reshape(B, nb, blk, H, Dh).transpose(1, 0, 2, 3, 4)
    qbs = qbp.reshape(B, nb, blk, H).transpose(1, 0, 3, 2)
    ps = posp.reshape(nb, blk)
    kb_t = kb.transpose(0, 2, 1)[:, :, None, :]
    scale = HEAD_DIM ** -0.5

    def block(args):
        qblk, qbblk, pblk = args
        s = jnp.einsum('bqhd,bkhd->bhqk', qblk, k, preferred_element_type=jnp.float32) * scale
        s = s + qbblk[..., None] + kb_t
        mask = k_pos[None, :] <= pblk[:, None]
        s = jnp.where(mask[None, None], s, NEG_INF)
        p = jax.nn.softmax(s, axis=-1)
        return jnp.einsum('bhqk,bkhd->bqhd', p.astype(v.dtype), v)

    o = lax.map(block, (qs, qbs, ps))
    return o.transpose(1, 0, 2, 3, 4).reshape(B, nb * blk, H, Dh)[:, :Lq]


def mixer_layer(x, pool_buf, pos0, past, norm_gain, w_in, b_f, q_gain, k_gain,
                w_pool_map, pool_scale, w_up_pool, w_up_attn, w_out):
    B, L, _ = x.shape
    xn = rms_norm(x, norm_gain)
    h = xn @ w_in
    splits = [int(s) for s in np.cumsum(IN_SIZES)[:-1]]
    u, gp, q, k, v, ga, fl, m_a, m_b = jnp.split(h, splits, axis=-1)
    q = rms_norm(q.reshape(B, L, N_HEADS, HEAD_DIM), q_gain)
    k = rms_norm(k.reshape(B, L, N_HEADS, HEAD_DIM), k_gain)
    v = v.reshape(B, L, N_HEADS, HEAD_DIM)
    logf = jax.nn.log_sigmoid(fl.astype(jnp.float32) + b_f.astype(jnp.float32))
    f_new = jnp.cumsum(logf, axis=1)
    if past is None:
        qb, kb, K, V = f_new, -f_new, k, v
        q_pos = jnp.arange(L)
        k_pos = q_pos
    else:
        past_k, past_v, past_lf = past
        P = past_k.shape[1]
        plf = past_lf.astype(jnp.float32)
        rest = lax.cumsum(plf, axis=1, reverse=True) - plf
        qb = f_new
        kb = jnp.concatenate([rest, -f_new], axis=1)
        K = jnp.concatenate([past_k.astype(k.dtype), k], axis=1)
        V = jnp.concatenate([past_v.astype(v.dtype), v], axis=1)
        q_pos = P + jnp.arange(L)
        k_pos = jnp.arange(P + L)
    att = forgetting_attention(q, K, V, qb, kb, q_pos, k_pos).reshape(B, L, ATTN_WIDTH)
    branch_b = att * jax.nn.silu(ga)
    branch_a = pool_mixer(u, pool_buf, pos0, w_pool_map, pool_scale) * jax.nn.silu(gp)
    new_buf = jnp.concatenate([pool_buf.astype(u.dtype), u], axis=1)[:, -POOL_BUF:]
    merged = jax.nn.sigmoid(m_a) * (branch_a @ w_up_pool) + jax.nn.sigmoid(m_b) * (branch_b @ w_up_attn)
    y = x + merged @ w_out
    return y, k, v, logf, new_buf


def setup_inputs(seed: int = 0) -> dict:
    key = jax.random.key(seed)
    ks = jax.random.split(key, 20)
    n_pages = PAST_LEN // PAGE_SIZE
    n_used = DEC_BATCH * n_pages
    n_phys = n_used + n_used // 4
    f32 = jnp.float32
    x_prompt = jax.random.normal(ks[0], (BATCH, SEQ, D_MODEL), f32)
    x_sample = jax.random.normal(ks[1], (DEC_BATCH, DEC_SEQ, D_MODEL), f32)
    cache_k = jax.random.normal(ks[2], (DEPTH, n_phys, PAGE_SIZE, N_HEADS, HEAD_DIM), f32)
    cache_v = jax.random.normal(ks[3], (DEPTH, n_phys, PAGE_SIZE, N_HEADS, HEAD_DIM), f32)
    cache_logf = jax.nn.log_sigmoid(jax.random.uniform(ks[4], (DEPTH, n_phys, PAGE_SIZE, N_HEADS), f32, 3.0, 7.0))
    state_pool = jax.random.normal(ks[5], (DEPTH, DEC_BATCH, POOL_BUF, POOL_WIDTH), f32)
    page_table = jax.random.permutation(ks[6], n_phys)[:n_used].reshape(DEC_BATCH, n_pages).astype(jnp.int32)
    norm_gain = 1.0 + 0.02 * jax.random.normal(ks[7], (DEPTH, D_MODEL), f32)
    w_in = jax.random.normal(ks[8], (DEPTH, D_MODEL, IN_COLS), f32) * D_MODEL ** -0.5
    b_f = jax.random.uniform(ks[9], (DEPTH, N_HEADS), f32, 3.0, 6.0)
    q_norm_gain = 1.0 + 0.02 * jax.random.normal(ks[10], (DEPTH, HEAD_DIM), f32)
    k_norm_gain = 1.0 + 0.02 * jax.random.normal(ks[11], (DEPTH, HEAD_DIM), f32)
    w_pool_map = jax.random.normal(ks[12], (DEPTH, N_POOL_GROUPS, POOL_GROUP, POOL_GROUP), f32) * POOL_GROUP ** -0.5
    pool_scale = 1.0 + 0.02 * jax.random.normal(ks[13], (DEPTH, POOL_WIDTH), f32)
    w_up_pool = jax.random.normal(ks[14], (DEPTH, POOL_WIDTH, D_MODEL), f32) * POOL_WIDTH ** -0.5
    w_up_attn = jax.random.normal(ks[15], (DEPTH, ATTN_WIDTH, D_MODEL), f32) * ATTN_WIDTH ** -0.5
    w_out = jax.random.normal(ks[16], (DEPTH, D_MODEL, D_MODEL), f32) * D_MODEL ** -0.5
    return {"x_prompt": x_prompt, "x_sample": x_sample, "cache_k": cache_k, "cache_v": cache_v,
            "cache_logf": cache_logf, "state_pool": state_pool, "page_table": page_table,
            "norm_gain": norm_gain, "w_in": w_in, "b_f": b_f, "q_norm_gain": q_norm_gain,
            "k_norm_gain": k_norm_gain, "w_pool_map": w_pool_map, "pool_scale": pool_scale,
            "w_up_pool": w_up_pool, "w_up_attn": w_up_attn, "w_out": w_out}


def reference(x_prompt, x_sample, cache_k, cache_v, cache_logf, state_pool, page_table,
              norm_gain, w_in, b_f, q_norm_gain, k_norm_gain, w_pool_map, pool_scale,
              w_up_pool, w_up_attn, w_out):
    dec_b, n_pages = page_table.shape
    past_len = n_pages * PAGE_SIZE
    yp, ys = x_prompt, x_sample
    kp_l, vp_l, lfp_l, bp_l, ks_l, vs_l, lfs_l, bs_l = [], [], [], [], [], [], [], []
    for l in range(DEPTH):
        params = (norm_gain[l], w_in[l], b_f[l], q_norm_gain[l], k_norm_gain[l],
                  w_pool_map[l], pool_scale[l], w_up_pool[l], w_up_attn[l], w_out[l])
        zero_buf = jnp.zeros((x_prompt.shape[0], POOL_BUF, POOL_WIDTH), x_prompt.dtype)
        yp, kp, vp, lfp, bp = mixer_layer(yp, zero_buf, 0, None, *params)
        past_k = cache_k[l][page_table].reshape(dec_b, past_len, N_HEADS, HEAD_DIM)
        past_v = cache_v[l][page_table].reshape(dec_b, past_len, N_HEADS, HEAD_DIM)
        past_lf = cache_logf[l][page_table].reshape(dec_b, past_len, N_HEADS)
        ys, ksm, vsm, lfs, bs = mixer_layer(ys, state_pool[l], past_len, (past_k, past_v, past_lf), *params)
        kp_l.append(kp); vp_l.append(vp); lfp_l.append(lfp); bp_l.append(bp)
        ks_l.append(ksm); vs_l.append(vsm); lfs_l.append(lfs); bs_l.append(bs)
    return (yp, ys, jnp.stack(kp_l), jnp.stack(vp_l), jnp.stack(lfp_l), jnp.stack(bp_l),
            jnp.stack(ks_l), jnp.stack(vs_l), jnp.stack(lfs_l), jnp.stack(bs_l))
```

```cpp
#include <hip/hip_runtime.h>
#include <hip/hip_bf16.h>
#include <cstdio>
#include <cstdint>
#include <cmath>

__device__ __forceinline__ int tid_fresh() { int t = threadIdx.x; asm volatile("" : "+v"(t)); return t; }
namespace pg8 {
#define PG8_LAS __attribute__((address_space(3)))
typedef unsigned short bf16_t;
typedef short bf16x8 __attribute__((ext_vector_type(8)));
typedef float f32x4 __attribute__((ext_vector_type(4)));
typedef unsigned u32x4 __attribute__((ext_vector_type(4)));
constexpr int BM = 256, BK = 64, HALF = 128, HTB = HALF * BK * 2  , STAGE_BYTES = 8 * HTB, NXCD = 8, WGM = 8;

__host__ __device__ __forceinline__ int lds_byte(int r, int c) { const int st = (r >> 4) * 2 + (c >> 5), rr = r & 15, cc = c & 31, ob = rr * 64 + cc * 2; return st * 1024 + (ob ^ (((ob >> 9) & 1) << 5)); }
__host__ __device__ __forceinline__ void stage_rc(int b, int& R, int& C) { const int st = b / 1024, sb = b % 1024, swz = sb ^ (((sb >> 9) & 1) << 5); R = (st >> 1) * 16 + swz / 64; C = (st & 1) * 32 + (swz % 64) / 2; }
__host__ __device__ __forceinline__ int perm32(int rho) { const int n = rho >> 4, i = rho & 15; return 8 * (i >> 2) + 4 * n + (i & 3); }

struct Unit { int pm, pn, aux; const char* a; const char* b; };
struct Gemm { int lda, ldb, K; };

__device__ __forceinline__ bool static_tile(int i, int G, int c, int nM, int nN, int& pm, int& pn) {
    const int nwg = nM * nN; const long L = (long)i * G + c; if (L >= nwg) return false;
    int wgid = (int)L; { const int q = nwg / NXCD, r = nwg % NXCD, xcd = wgid % NXCD, off = wgid / NXCD; wgid = (xcd < r ? xcd * (q + 1) : r * (q + 1) + (xcd - r) * q) + off; }
    const int nig = WGM * nN, gid = wgid / nig, fm = gid * WGM, gsz = (nM - fm) < WGM ? (nM - fm) : WGM;
    pm = fm + ((wgid % nig) % gsz); pn = (wgid % nig) / gsz; return true;
}
__device__ __forceinline__ unsigned cvt_pk_bf16(float lo, float hi) { unsigned r; asm volatile("v_cvt_pk_bf16_f32 %0, %1, %2" : "=v"(r) : "v"(lo), "v"(hi)); return r; }

template <class Epi, class Sched, bool ALIGN_EPI = false, bool SP2 = false>
__device__ __forceinline__ void gemm_phase(PG8_LAS unsigned char* lds, const Gemm g, const Sched& S, const Epi& E) {
    const int tid = tid_fresh(), wid = __builtin_amdgcn_readfirstlane(tid >> 6), lane = tid & 63, wr = wid >> 2, wc = wid & 3, fr = lane & 15, fq = lane >> 4;
    const int K = g.K, nt = K / BK;
    unsigned voffA[2], voffB[2];
#pragma unroll
    for (int i = 0; i < 2; ++i) { int R, C; stage_rc(tid * 16 + i * 8192, R, C); const int Rb = Epi::PERM ? ((R & ~31) + perm32(R & 31)) : R;
        voffA[i] = (unsigned)(R * g.lda + C) * 2u; voffB[i] = (unsigned)(Rb * g.ldb + C) * 2u; }
    const size_t kstep = (size_t)(BK * 2);
    const size_t hA = (size_t)HALF * g.lda * 2, hB = (size_t)HALF * g.ldb * 2;
    const unsigned ldsw = (unsigned)wid * 1024u;
    const int aoff = lds_byte(wr * 64 + fr, fq * 8), boff = lds_byte(wc * 32 + fr, fq * 8);
#define PG8_SA(b, h) (((b) * 2 + (h)) * HTB)
#define PG8_SB(b, h) ((4 + (b) * 2 + (h)) * HTB)
#define PG8_STAGE(bufoff, gbase, voff) do { _Pragma("unroll") for (int _i = 0; _i < 2; ++_i) \
        __builtin_amdgcn_global_load_lds((const unsigned*)((const char*)(gbase) + (voff)[_i]), (PG8_LAS unsigned*)(lds + (bufoff) + ldsw + _i * 8192), 16, 0, 0); } while (0)
#define PG8_LDA(dst, b, h) do { _Pragma("unroll") for (int m = 0; m < 4; ++m) _Pragma("unroll") for (int k = 0; k < 2; ++k) dst[m][k] = *(const PG8_LAS bf16x8*)(lds + PG8_SA(b, h) + aoff + m * 2048 + k * 1024); } while (0)
#define PG8_LDB(dst, b, h) do { _Pragma("unroll") for (int n = 0; n < 2; ++n) _Pragma("unroll") for (int k = 0; k < 2; ++k) dst[n][k] = *(const PG8_LAS bf16x8*)(lds + PG8_SB(b, h) + boff + n * 2048 + k * 1024); } while (0)
#define PG8_MMA(ai, bj, At, Bt) do { __builtin_amdgcn_s_setprio(1); _Pragma("unroll") for (int m = 0; m < 4; ++m) _Pragma("unroll") for (int n = 0; n < 2; ++n) _Pragma("unroll") for (int k = 0; k < 2; ++k) \
        acc[ai][bj][m][n] = __builtin_amdgcn_mfma_f32_16x16x32_bf16(Bt[n][k], At[m][k], acc[ai][bj][m][n], 0, 0, 0); __builtin_amdgcn_s_setprio(0); } while (0)
#define PG8_WAIT_V(n) asm volatile("s_waitcnt vmcnt(" #n ")" ::: "memory")
#define PG8_WAIT_L(n) asm volatile("s_waitcnt lgkmcnt(" #n ")" ::: "memory")
#define PG8_BAR __builtin_amdgcn_s_barrier()
#define PG8_SCHED __builtin_amdgcn_sched_barrier(0)
    Unit cur, nxt; int ui = 0;
    if (!S.next(0, cur)) return;
    f32x4 acc[2][2][4][2];
#pragma unroll
    for (int a = 0; a < 2; ++a)
#pragma unroll
        for (int b = 0; b < 2; ++b)
#pragma unroll
            for (int m = 0; m < 4; ++m)
#pragma unroll
                for (int n = 0; n < 2; ++n) acc[a][b][m][n] = (f32x4){0.f, 0.f, 0.f, 0.f};
    bf16x8 At[4][2], B0[2][2], B1[2][2];
    const char* cA = cur.a; const char* cB = cur.b;
    S.a_ready(cur);
    if constexpr (SP2) {
        PG8_STAGE(PG8_SB(0, 0), cB, voffB); PG8_STAGE(PG8_SB(0, 1), cB + hB, voffB); PG8_STAGE(PG8_SA(0, 0), cA, voffA); PG8_STAGE(PG8_SA(0, 1), cA + hA, voffA);
        if (wr == 1) PG8_BAR;
        PG8_WAIT_V(2); PG8_BAR;
        PG8_STAGE(PG8_SB(1, 0), cB + kstep, voffB); PG8_STAGE(PG8_SA(1, 0), cA + kstep, voffA); PG8_STAGE(PG8_SB(1, 1), cB + hB + kstep, voffB);
        PG8_WAIT_V(6); PG8_BAR;
    } else {
        PG8_STAGE(PG8_SB(0, 0), cB, voffB); PG8_STAGE(PG8_SA(0, 0), cA, voffA); PG8_STAGE(PG8_SB(0, 1), cB + hB, voffB); PG8_STAGE(PG8_SA(0, 1), cA + hA, voffA);
        if (wr == 1) PG8_BAR;
        PG8_WAIT_V(4); PG8_BAR;
        PG8_STAGE(PG8_SB(1, 0), cB + kstep, voffB); PG8_STAGE(PG8_SA(1, 0), cA + kstep, voffA); PG8_STAGE(PG8_SB(1, 1), cB + hB + kstep, voffB);
        PG8_WAIT_V(6); PG8_BAR;
    }
    for (;;) {
        const bool has_next = S.next(ui + 1, nxt);
        const char* nA = has_next ? nxt.a : cA; const char* nB = has_next ? nxt.b : cB;
        for (int t = 0; t < nt; t += 2) {
            const bool last = (t == nt - 2);
            const char* a1 = cA + (size_t)(t + 1) * kstep;
            const char* a2 = last ? nA : cA + (size_t)(t + 2) * kstep; const char* b2 = last ? nB : cB + (size_t)(t + 2) * kstep;
            const char* a3 = a2 + kstep; const char* b3 = b2 + kstep;
            if (last && has_next) S.a_ready(nxt);
            if constexpr (SP2) {
            PG8_LDB(B0, 0, 0); PG8_LDB(B1, 0, 1); PG8_SCHED; PG8_LDA(At, 0, 0); PG8_STAGE(PG8_SA(1, 1), a1 + hA, voffA);
            PG8_WAIT_V(8); PG8_WAIT_L(0); PG8_BAR; PG8_MMA(0, 0, At, B0); PG8_MMA(0, 1, At, B1); PG8_BAR; PG8_SCHED;
            PG8_LDA(At, 0, 1); PG8_STAGE(PG8_SB(0, 0), b2, voffB); PG8_STAGE(PG8_SB(0, 1), b2 + hB, voffB); PG8_STAGE(PG8_SA(0, 0), a2, voffA);
            PG8_WAIT_V(8); PG8_WAIT_L(0); PG8_BAR; PG8_MMA(1, 0, At, B0); PG8_MMA(1, 1, At, B1); PG8_BAR; PG8_SCHED;
            PG8_LDB(B0, 1, 0); PG8_LDB(B1, 1, 1); PG8_SCHED; PG8_LDA(At, 1, 0); PG8_STAGE(PG8_SA(0, 1), a2 + hA, voffA);
            PG8_WAIT_V(8); PG8_WAIT_L(0); PG8_BAR; PG8_MMA(0, 0, At, B0); PG8_MMA(0, 1, At, B1); PG8_BAR; PG8_SCHED;
            PG8_LDA(At, 1, 1); PG8_STAGE(PG8_SB(1, 0), b3, voffB); PG8_STAGE(PG8_SB(1, 1), b3 + hB, voffB); PG8_STAGE(PG8_SA(1, 0), a3, voffA);
            PG8_WAIT_V(8); PG8_WAIT_L(0); PG8_BAR; PG8_MMA(1, 0, At, B0); PG8_MMA(1, 1, At, B1); PG8_BAR; PG8_SCHED;
            } else {
            PG8_LDB(B0, 0, 0); PG8_SCHED; PG8_LDA(At, 0, 0); PG8_STAGE(PG8_SA(1, 1), a1 + hA, voffA);
            PG8_WAIT_L(8); PG8_BAR; PG8_WAIT_L(0); PG8_MMA(0, 0, At, B0); PG8_BAR; PG8_SCHED;
            PG8_LDB(B1, 0, 1); PG8_STAGE(PG8_SB(0, 0), b2, voffB);
            PG8_BAR; PG8_WAIT_L(0); PG8_MMA(0, 1, At, B1); PG8_BAR;
            PG8_LDA(At, 0, 1); PG8_STAGE(PG8_SA(0, 0), a2, voffA);
            PG8_BAR; PG8_WAIT_L(0); PG8_MMA(1, 0, At, B0); PG8_BAR; PG8_SCHED;
            PG8_STAGE(PG8_SB(0, 1), b2 + hB, voffB);
            PG8_WAIT_V(6); PG8_BAR; PG8_MMA(1, 1, At, B1); PG8_BAR;
            PG8_LDB(B0, 1, 0); PG8_SCHED; PG8_LDA(At, 1, 0); PG8_STAGE(PG8_SA(0, 1), a2 + hA, voffA);
            PG8_WAIT_L(8); PG8_BAR; PG8_WAIT_L(0); PG8_MMA(0, 0, At, B0); PG8_BAR; PG8_SCHED;
            PG8_LDB(B1, 1, 1); PG8_STAGE(PG8_SB(1, 0), b3, voffB);
            PG8_BAR; PG8_WAIT_L(0); PG8_MMA(0, 1, At, B1); PG8_BAR;
            PG8_LDA(At, 1, 1); PG8_STAGE(PG8_SA(1, 0), a3, voffA);
            PG8_BAR; PG8_WAIT_L(0); PG8_MMA(1, 0, At, B0); PG8_BAR; PG8_SCHED;
            PG8_STAGE(PG8_SB(1, 1), b3 + hB, voffB);
            PG8_WAIT_V(6); PG8_BAR; PG8_MMA(1, 1, At, B1); PG8_BAR;
            }
        }
        if constexpr (ALIGN_EPI) { if (wr == 0) PG8_BAR; }
        if constexpr (!Epi::AFTER_DRAIN) { E(acc, cur, wr, wc, fr, fq); S.done(cur); }
        if (!has_next) break;
#pragma unroll
        for (int a = 0; a < 2; ++a)
#pragma unroll
            for (int b = 0; b < 2; ++b)
#pragma unroll
                for (int m = 0; m < 4; ++m)
#pragma unroll
                    for (int n = 0; n < 2; ++n) acc[a][b][m][n] = (f32x4){0.f, 0.f, 0.f, 0.f};
        cur = nxt; cA = nA; cB = nB; ++ui;
        if constexpr (ALIGN_EPI) { if (wr == 1) PG8_BAR; }
    }
    PG8_WAIT_V(0);
    if constexpr (!ALIGN_EPI) { if (wr == 0) PG8_BAR; }
    PG8_BAR;
    if constexpr (Epi::AFTER_DRAIN) { E.fused(acc, cur, wr, wc, fr, fq, lds, wid, lane); S.done(cur); }
#undef PG8_SA
#undef PG8_SB
#undef PG8_STAGE
#undef PG8_LDA
#undef PG8_LDB
#undef PG8_MMA
#undef PG8_WAIT_V
#undef PG8_WAIT_L
#undef PG8_BAR
#undef PG8_SCHED
}
}

#include <hip/hip_bf16.h>
#include <cmath>
namespace attn_body {
using bf16=__hip_bfloat16;
using bf16x8=__attribute__((ext_vector_type(8)))short;
using s16x4=__attribute__((ext_vector_type(4)))short;
using f32x16=__attribute__((ext_vector_type(16)))float;
using u32x4=__attribute__((ext_vector_type(4)))unsigned;
constexpr int BATCH=4,NHEAD=16,SEQ=2048,D=64,DM=NHEAD*D,OPITCH=2048;
constexpr int NW=8,QBLK=32,QB=QBLK*NW,KVBLK=64,NQB=SEQ/QB;
constexpr int ATTN_PITCH=DM, ATTN_UNIT_ROWS=QB;
__device__ __forceinline__ int crow(int r,int hi){return (r&3)+8*(r>>2)+4*hi;}
#define SBAR() __builtin_amdgcn_sched_barrier(0)
__device__ __forceinline__ void cmask(f32x16&p0,f32x16&p1,int jb,int qrel,int hi){
  const float NEG=-INFINITY; int kb=64*jb+4*hi;
  #pragma unroll
  for(int r=0;r<16;++r){int kv=kb+(r&3)+8*(r>>2); if(kv>qrel)p0[r]=NEG; if(kv+32>qrel)p1[r]=NEG;}
}

constexpr int NSLOT=3, SLOTB=8192;
constexpr int LDS_K=0, LDS_V=NSLOT*SLOTB, LDS_WS=2*NSLOT*SLOTB, LDS_OST=LDS_WS+NW*64*4, LDS_FS2=LDS_OST+NW*4096, LDS_BYTES=LDS_FS2+SEQ*4;
constexpr float C2=0.125f*1.4426950408889634f;
__device__ __forceinline__ void glds16(const void*gsrc,unsigned lds_dst){unsigned keep;
  asm volatile("s_mov_b32 %0, m0\n\ts_mov_b32 m0, %2\n\ts_nop 0\n\tglobal_load_lds_dwordx4 %1, off\n\ts_mov_b32 m0, %0":"=&s"(keep):"v"(gsrc),"s"(lds_dst):"memory");}
__device__ __forceinline__ float max3f(float a,float b,float c){float r;asm("v_max3_f32 %0, %1, %2, %3":"=v"(r):"v"(a),"v"(b),"v"(c));return r;}
__device__ __forceinline__ float max2f(float a,float b){float r;asm("v_max_f32_e32 %0, %1, %2":"=v"(r):"v"(a),"v"(b));return r;}
__device__ __forceinline__ float fadd_s(float a,float b){float r;asm("v_add_f32_e32 %0, %1, %2":"=v"(r):"v"(a),"v"(b));return r;}
__device__ __forceinline__ float fsub_s(float a,float b){float r;asm("v_sub_f32_e32 %0, %1, %2":"=v"(r):"v"(a),"v"(b));return r;}
typedef float f32x2_t __attribute__((ext_vector_type(2))); typedef __bf16 bf16x2_t __attribute__((ext_vector_type(2)));
__device__ __forceinline__ unsigned cvtpk_s(float lo,float hi){f32x2_t v={lo,hi};bf16x2_t b=__builtin_convertvector(v,bf16x2_t);return __builtin_bit_cast(unsigned,b);}
#define WAIT_BAR(N) asm volatile("s_waitcnt vmcnt(" #N ") lgkmcnt(0)\n\ts_barrier":::"memory")

__device__ __forceinline__ void qkt(f32x16&p0,f32x16&p1,const char*Kslot,const bf16x8*qr,int r32,int hi){
  const char*kb=Kslot+hi*1024+r32*16;
  #pragma unroll
  for(int d0=0;d0<4;++d0){
    const bf16x8 b0=*reinterpret_cast<const bf16x8*>(kb+d0*2048);
    const bf16x8 b1=*reinterpret_cast<const bf16x8*>(kb+d0*2048+512);
    {p0=__builtin_amdgcn_mfma_f32_32x32x16_bf16(b0,qr[d0],p0,0,0,0);p1=__builtin_amdgcn_mfma_f32_32x32x16_bf16(b1,qr[d0],p1,0,0,0);}}
}
typedef __attribute__((address_space(3))) const char* lds_cptr;
typedef short v4i16_t __attribute__((ext_vector_type(4)));
__device__ __forceinline__ void kload8(bf16x8*kf,lds_cptr kp){
  kf[0]=*(const __attribute__((address_space(3))) bf16x8*)(kp);      kf[1]=*(const __attribute__((address_space(3))) bf16x8*)(kp+512);
  kf[2]=*(const __attribute__((address_space(3))) bf16x8*)(kp+2048); kf[3]=*(const __attribute__((address_space(3))) bf16x8*)(kp+2560);
  kf[4]=*(const __attribute__((address_space(3))) bf16x8*)(kp+4096); kf[5]=*(const __attribute__((address_space(3))) bf16x8*)(kp+4608);
  kf[6]=*(const __attribute__((address_space(3))) bf16x8*)(kp+6144); kf[7]=*(const __attribute__((address_space(3))) bf16x8*)(kp+6656);
}
__device__ __forceinline__ void kload2(bf16x8*kf,lds_cptr kp,int j){ kf[2*j]=*(const __attribute__((address_space(3))) bf16x8*)(kp+j*2048); kf[2*j+1]=*(const __attribute__((address_space(3))) bf16x8*)(kp+j*2048+512); }
__device__ __forceinline__ s16x4 vtr(lds_cptr p){ return __builtin_bit_cast(s16x4,__builtin_amdgcn_ds_read_tr16_b64_v4i16((__attribute__((address_space(3))) v4i16_t*)p)); }
__device__ __forceinline__ float rowmax(const f32x16&p0,const f32x16&p1){
  float a=max3f(p0[0],p0[1],p1[0]),b=max3f(p0[2],p0[3],p1[1]);a=max3f(a,p1[2],p1[3]);
  #pragma unroll
  for(int r=4;r<16;r+=4){a=max3f(a,p0[r],p0[r+1]);b=max3f(b,p0[r+2],p0[r+3]);a=max3f(a,p1[r],p1[r+1]);b=max3f(b,p1[r+2],p1[r+3]);}
  const float m=max2f(a,b);
  auto rr=__builtin_amdgcn_permlane32_swap(__float_as_uint(m),__float_as_uint(m),false,false);
  return max2f(__uint_as_float(rr[0]),__uint_as_float(rr[1]));
}
__device__ __forceinline__ void pv(f32x16*o,int vb,bf16x8 pa0,bf16x8 pa1,bf16x8 pa2,bf16x8 pa3){
  #pragma unroll
  for(int d0=0;d0<2;++d0){s16x4 lo[4],hi[4];
    #pragma unroll
    for(int ks=0;ks<4;++ks){
      asm volatile("ds_read_b64_tr_b16 %0,%1 offset:%c2":"=&v"(lo[ks]):"v"(vb),"i"(d0*4096+ks*1024):"memory");
      asm volatile("ds_read_b64_tr_b16 %0,%1 offset:%c2":"=&v"(hi[ks]):"v"(vb),"i"(d0*4096+ks*1024+512):"memory");}
    asm volatile("s_waitcnt lgkmcnt(0)":::"memory");SBAR();
    #define PK(k) (bf16x8){lo[k][0],lo[k][1],lo[k][2],lo[k][3],hi[k][0],hi[k][1],hi[k][2],hi[k][3]}
    o[d0]=__builtin_amdgcn_mfma_f32_32x32x16_bf16(pa0,PK(0),o[d0],0,0,0);
    o[d0]=__builtin_amdgcn_mfma_f32_32x32x16_bf16(pa1,PK(1),o[d0],0,0,0);
    o[d0]=__builtin_amdgcn_mfma_f32_32x32x16_bf16(pa2,PK(2),o[d0],0,0,0);
    o[d0]=__builtin_amdgcn_mfma_f32_32x32x16_bf16(pa3,PK(3),o[d0],0,0,0);
    #undef PK
  }
}

#ifndef ATTN_STORE16
#define ATTN_STORE16(p,v) (*(u32x4*)(p)=(v))
#endif
template<int THRL> __device__ __forceinline__ void attn_unit(int b,int h,int qb,const bf16*Q,const bf16*__restrict__ K,const bf16*__restrict__ V,const bf16*__restrict__ G,bf16*O,char*shm){
  const int tid=tid_fresh(),lane=tid&63,r32=lane&31,hi=lane>>5; const int wid=__builtin_amdgcn_readfirstlane(tid>>6);
  const long rowbase=(long)b*SEQ; const int q0=qb*QB;
  const bf16*Qw=Q+(rowbase+q0+wid*QBLK)*DM+h*D;
  const bf16*Kh=K+rowbase*DM+h*D,*Vh=V+rowbase*DM+h*D;
  const unsigned lds0=(unsigned)(uintptr_t)shm;
  float*wsf=(float*)(shm+LDS_WS)+wid*64;
  const bf16*ksrc=Kh+(long)lane*DM+wid*8;
  const bf16*vsrc=Vh+(long)(16*(wid&3)+(lane>>2))*DM+(wid>>2)*32+(lane&3)*8;
  const unsigned kdst=lds0+LDS_K+wid*1024, vdst=lds0+LDS_V+wid*1024;
  #define DMA_K(t,slot) glds16(ksrc+(long)(t)*KVBLK*DM,(unsigned)__builtin_amdgcn_readfirstlane(kdst+(slot)))
  #define DMA_V(t,slot) glds16(vsrc+(long)(t)*KVBLK*DM,(unsigned)__builtin_amdgcn_readfirstlane(vdst+(slot)))
  const int vb0=(int)(lds0+LDS_V)+((lane>>4)&1)*32+(lane&3)*8+(4*hi+((lane&15)>>2))*64;
  const char*Kbase=shm+LDS_K; bf16x8 kf[8];
  const lds_cptr shm3=(lds_cptr)shm; const lds_cptr kp0=shm3+LDS_K+hi*1024+r32*16; const lds_cptr vp0=shm3+LDS_V+((lane>>4)&1)*32+(lane&3)*8+(4*hi+((lane&15)>>2))*64;
  typedef float f32x4a __attribute__((ext_vector_type(4)));
  const __attribute__((address_space(3))) f32x4a* fsb=(const __attribute__((address_space(3))) f32x4a*)(shm3+LDS_FS2)+hi;
  #define BINIT(P,t,o32) do{ const __attribute__((address_space(3))) f32x4a* fb_=fsb+(t)*16+(o32)*8; \
    _Pragma("unroll") for(int rg_=0;rg_<4;++rg_){ const f32x4a b0_=fb_[2*rg_]; \
      P[4*rg_]=b0_[0]-mhat;P[4*rg_+1]=b0_[1]-mhat;P[4*rg_+2]=b0_[2]-mhat;P[4*rg_+3]=b0_[3]-mhat; } asm volatile("":"+v"(P)); SBAR(); }while(0)
  const int NT=(q0+QB)/KVBLK;
  DMA_K(0,0);DMA_V(0,0);DMA_K(1,SLOTB);
  bf16x8 qr[4];
  #pragma unroll
  for(int d0=0;d0<4;++d0)qr[d0]=*reinterpret_cast<const bf16x8*>(&Qw[(long)r32*DM+d0*16+hi*8]);
  float mhat=0.f,l_reg=0.f;f32x16 o[2];o[0]=f32x16{};o[1]=f32x16{};
  const int qrel=wid*QBLK+r32;
  #define CMASK(P0,P1,t) do{int jb_=(t)-(NT-4); if(jb_>=0)cmask(P0,P1,jb_,qrel,hi);}while(0)
  bool resc=false;
  #define START(P0,P1) do{ const float rm=rowmax(P0,P1); resc=false; \
    { const float dl=rm; mhat=fadd_s(mhat,dl); \
      _Pragma("unroll") for(int r=0;r<16;++r){P0[r]=fsub_s(P0[r],dl);P1[r]=fsub_s(P1[r],dl);} \
      } \
    _Pragma("unroll") for(int r=0;r<16;++r)P0[r]=__builtin_amdgcn_exp2f(P0[r]); }while(0)
  #define RESC() do{ if(resc){ asm volatile("s_waitcnt lgkmcnt(0)":::"memory"); \
      _Pragma("unroll") for(int d_=0;d_<2;++d_) _Pragma("unroll") for(int r=0;r<16;++r)o[d_][r]*=wsf[crow(r,hi)]; } }while(0)
  f32x16 pA0,pA1,pB0,pB1;
  int sl_prev=0,sl_cur=0,sl_next=SLOTB;
  #define ROT() do{sl_prev=sl_cur;sl_cur=sl_next;sl_next=(sl_next==(NSLOT-1)*SLOTB)?0:sl_next+SLOTB;}while(0)
  DMA_K(2,2*SLOTB);
  WAIT_BAR(3);
  BINIT(pA0,0,0);BINIT(pA1,0,1);qkt(pA0,pA1,Kbase,qr,r32,hi);asm volatile("s_nop 15\n\ts_nop 7":"+v"(pA0),"+v"(pA1));CMASK(pA0,pA1,0);
  START(pA0,pA1);
  _Pragma("unroll") for(int r=0;r<16;++r)pA1[r]=__builtin_amdgcn_exp2f(pA1[r]);
  WAIT_BAR(0);
  DMA_K(3,0);DMA_V(1,SLOTB);
  ROT();
  kload8(kf,kp0+sl_cur);
  WAIT_BAR(2);
  s16x4 vlo[8],vhi[8]; u32x4 pw0,pw1,pw2,pw3;
  #define PKW(P,B) cvtpk_s(P[B],P[B+1])
  #define PAF(k) __builtin_bit_cast(bf16x8,pw##k)
  #define VFR(i) (bf16x8){vlo[i][0],vlo[i][1],vlo[i][2],vlo[i][3],vhi[i][0],vhi[i][1],vhi[i][2],vhi[i][3]}
  #define PIN(x) asm volatile("":"+v"(x))
  #define MX3(a,b,c) __builtin_fmaxf(__builtin_fmaxf((a),(b)),(c))
  #define GAPA(MF,A0,A1,A2,A3,W0,W1,PW) do{ MF; sacc+=A0; sacc+=A1; sacc+=A2; sacc+=A3; PIN(sacc); W0; W1; PIN(PW); SBAR(); }while(0)
  #define EX(v) __builtin_amdgcn_exp2f(v)
  #define GAPB(MF,X,B) do{ MF; X[B]=EX(X[B]); X[B+1]=EX(X[B+1]); X[B+2]=EX(X[B+2]); X[B+3]=EX(X[B+3]); PIN(X); SBAR(); }while(0)
  #define VRD(i) do{ vlo[i]=vtr(vp_+(((i)>>2)*4096+((i)&3)*1024)); vhi[i]=vtr(vp_+(((i)>>2)*4096+((i)&3)*1024+512)); }while(0)
  #define KRD(G,j) do{ if(G){ kload2(kf,kp0+sl_next,j); SBAR(); } }while(0)
  #define STEP(C0,C1,P0,P1,t,GK,GV,GL) do{ SBAR(); \
    const lds_cptr vp_=vp0+sl_prev; \
    BINIT(C0,t,0); VRD(0); SBAR(); float sacc=(P0[0]+P0[1]); \
    GAPA(C0=__builtin_amdgcn_mfma_f32_32x32x16_bf16(kf[0],qr[0],C0,0,0,0), P0[2],P0[3],P0[4],P0[5],     pw0[0]=PKW(P0,0), pw0[1]=PKW(P0,2), pw0); \
    BINIT(C1,t,1); VRD(4); SBAR(); GAPA(C1=__builtin_amdgcn_mfma_f32_32x32x16_bf16(kf[1],qr[0],C1,0,0,0), P0[6],P0[7],P0[8],P0[9],     pw0[2]=PKW(P0,4), pw0[3]=PKW(P0,6), pw0); \
    VRD(1); SBAR(); GAPA(C0=__builtin_amdgcn_mfma_f32_32x32x16_bf16(kf[2],qr[1],C0,0,0,0),   P0[10],P0[11],P0[12],P0[13], pw1[0]=PKW(P0,8), pw1[1]=PKW(P0,10), pw1); \
    VRD(5); SBAR(); GAPA(C1=__builtin_amdgcn_mfma_f32_32x32x16_bf16(kf[3],qr[1],C1,0,0,0),   P0[14],P0[15],P1[0],P1[1],   pw1[2]=PKW(P0,12),pw1[3]=PKW(P0,14), pw1); \
    VRD(2); SBAR(); GAPA(C0=__builtin_amdgcn_mfma_f32_32x32x16_bf16(kf[4],qr[2],C0,0,0,0),   P1[2],P1[3],P1[4],P1[5],     pw2[0]=PKW(P1,0), pw2[1]=PKW(P1,2), pw2); \
    VRD(6); SBAR(); GAPA(C1=__builtin_amdgcn_mfma_f32_32x32x16_bf16(kf[5],qr[2],C1,0,0,0),   P1[6],P1[7],P1[8],P1[9],     pw2[2]=PKW(P1,4), pw2[3]=PKW(P1,6), pw2); \
    VRD(3); SBAR(); GAPA(C0=__builtin_amdgcn_mfma_f32_32x32x16_bf16(kf[6],qr[3],C0,0,0,0),   P1[10],P1[11],P1[12],P1[13], pw3[0]=PKW(P1,8), pw3[1]=PKW(P1,10), pw3); \
    VRD(7); SBAR(); GAPA(C1=__builtin_amdgcn_mfma_f32_32x32x16_bf16(kf[7],qr[3],C1,0,0,0),   P1[14],P1[15],0.f,0.f,       pw3[2]=PKW(P1,12),pw3[3]=PKW(P1,14), pw3); \
    l_reg+=sacc; \
    if(GK){DMA_K((t)+3,sl_cur);} if(GV){DMA_V((t)+1,sl_next);} \
    CMASK(C0,C1,t); \
    { float a=MX3(C0[0],C0[1],C1[0]),b=MX3(C0[2],C0[3],C1[1]); a=MX3(a,C1[2],C1[3]); \
      _Pragma("unroll") for(int r=4;r<16;r+=4){a=MX3(a,C0[r],C0[r+1]);b=MX3(b,C0[r+2],C0[r+3]);a=MX3(a,C1[r],C1[r+1]);b=MX3(b,C1[r+2],C1[r+3]);} \
      float rm=__builtin_fmaxf(a,b); { auto rr=__builtin_amdgcn_permlane32_swap(__float_as_uint(rm),__float_as_uint(rm),false,false); rm=__builtin_fmaxf(__uint_as_float(rr[0]),__uint_as_float(rr[1])); } \
      resc=false; \
      if(__builtin_expect(__any(rm>(float)THRL),0)){ const float dl=__builtin_fmaxf(rm,0.f); mhat+=dl; \
        _Pragma("unroll") for(int r=0;r<16;++r){C0[r]-=dl;C1[r]-=dl;} \
        const float f=__builtin_amdgcn_exp2f(-dl); l_reg*=f; if(hi==0)wsf[r32]=f; resc=true; } } \
    SBAR(); \
    GAPB(o[0]=__builtin_amdgcn_mfma_f32_32x32x16_bf16(PAF(0),VFR(0),o[0],0,0,0), C0,0); \
    GAPB(o[1]=__builtin_amdgcn_mfma_f32_32x32x16_bf16(PAF(0),VFR(4),o[1],0,0,0), C0,4); \
    KRD(GL,0); GAPB(o[0]=__builtin_amdgcn_mfma_f32_32x32x16_bf16(PAF(1),VFR(1),o[0],0,0,0), C0,8); \
    KRD(GL,1); GAPB(o[1]=__builtin_amdgcn_mfma_f32_32x32x16_bf16(PAF(1),VFR(5),o[1],0,0,0), C0,12); \
    KRD(GL,2); GAPB(o[0]=__builtin_amdgcn_mfma_f32_32x32x16_bf16(PAF(2),VFR(2),o[0],0,0,0), C1,0); \
    KRD(GL,3); GAPB(o[1]=__builtin_amdgcn_mfma_f32_32x32x16_bf16(PAF(2),VFR(6),o[1],0,0,0), C1,4); \
    GAPB(o[0]=__builtin_amdgcn_mfma_f32_32x32x16_bf16(PAF(3),VFR(3),o[0],0,0,0), C1,8); \
    GAPB(o[1]=__builtin_amdgcn_mfma_f32_32x32x16_bf16(PAF(3),VFR(7),o[1],0,0,0), C1,12); \
    }while(0)
  int t=1;
  #undef CMASK
  #define CMASK(P0,P1,t) do{}while(0)
  for(;t+5<NT;t+=2){
    STEP(pB0,pB1,pA0,pA1,t,true,true,true);     WAIT_BAR(2); RESC(); ROT();
    STEP(pA0,pA1,pB0,pB1,t+1,true,true,true);   WAIT_BAR(2); RESC(); ROT();
  }
  #undef CMASK
  #define CMASK(P0,P1,t) do{int jb_=(t)-(NT-4); if(jb_>=0)cmask(P0,P1,jb_,qrel,hi);}while(0)
  #define ENDW(tt) do{ if((tt)+3<NT){WAIT_BAR(2);} else if((tt)+2<NT){WAIT_BAR(1);} else {WAIT_BAR(0);} }while(0)
  for(;t+1<NT;t+=2){
    STEP(pB0,pB1,pA0,pA1,t,(t+3<NT),(t+1<NT),(t+1<NT));       ENDW(t);   RESC(); ROT();
    STEP(pA0,pA1,pB0,pB1,t+1,(t+4<NT),(t+2<NT),(t+2<NT));     ENDW(t+1); RESC(); ROT();
  }
  STEP(pB0,pB1,pA0,pA1,NT-1,false,false,false); RESC();
  { float sacc=pB0[0]+pB0[1]; _Pragma("unroll") for(int r=2;r<16;++r)sacc+=pB0[r]; _Pragma("unroll") for(int r=0;r<16;++r)sacc+=pB1[r]; l_reg+=sacc;
    pw0=(u32x4){PKW(pB0,0),PKW(pB0,2),PKW(pB0,4),PKW(pB0,6)};pw1=(u32x4){PKW(pB0,8),PKW(pB0,10),PKW(pB0,12),PKW(pB0,14)};pw2=(u32x4){PKW(pB1,0),PKW(pB1,2),PKW(pB1,4),PKW(pB1,6)};pw3=(u32x4){PKW(pB1,8),PKW(pB1,10),PKW(pB1,12),PKW(pB1,14)};
    SBAR(); pv(o,vb0+sl_cur,PAF(0),PAF(1),PAF(2),PAF(3)); }
  #undef PKW
  #undef PAF
  #undef VFR
  #undef PIN
  #undef MX3
  #undef GAPA
  #undef GAPB
  #undef EX
  #undef VRD
  #undef KRD
  #undef STEP
  #undef ENDW
  {auto rr=__builtin_amdgcn_permlane32_swap(__float_as_uint(l_reg),__float_as_uint(l_reg),false,false);l_reg=__uint_as_float(rr[0])+__uint_as_float(rr[1]);}
  if(hi==0)wsf[32+r32]=l_reg;asm volatile("s_waitcnt lgkmcnt(0)":::"memory");
  float rli[16];
  #pragma unroll
  for(int r=0;r<16;++r)rli[r]=__builtin_amdgcn_rcpf(wsf[32+crow(r,hi)]);
  bf16*Ow=O+(rowbase+q0+wid*QBLK)*OPITCH+h*D; const bf16*Gw=G+(rowbase+q0+wid*QBLK)*DM+h*D;
  { bf16*stg=(bf16*)(shm+LDS_OST)+wid*2048;
    #pragma unroll
    for(int r=0;r<16;++r){const int orow=crow(r,hi);
      #pragma unroll
      for(int d0=0;d0<2;++d0)stg[orow*64+d0*32+r32]=__float2bfloat16(o[d0][r]*rli[r]);}
    asm volatile("s_waitcnt lgkmcnt(0)":::"memory");
    #pragma unroll
    for(int i=0;i<4;++i){const int row=i*8+(lane>>3),ch=lane&7; const u32x4 v=*(const u32x4*)(stg+row*64+ch*8); const u32x4 gv=*(const u32x4*)(Gw+(long)row*DM+ch*8); u32x4 w;
      #pragma unroll
      for(int e=0;e<4;++e){ const float a0=__uint_as_float(v[e]<<16)*__uint_as_float(gv[e]<<16), a1=__uint_as_float(v[e]&0xffff0000u)*__uint_as_float(gv[e]&0xffff0000u); w[e]=cvtpk_s(a0,a1); }
      ATTN_STORE16(Ow+(long)row*OPITCH+ch*8,w);} }
  asm volatile("s_waitcnt lgkmcnt(0)\n\ts_barrier":::"memory");
  #undef DMA_K
  #undef DMA_V
  #undef CMASK
  #undef START
  #undef RESC
  #undef ROT
  #undef BINIT
}
typedef float f32x4w __attribute__((ext_vector_type(4)));
__device__ __forceinline__ void bias_table(char*shm,const float*logf,int b,int h){
  const int tid=tid_fresh(),lane=tid&63,wid=tid>>6; float*ws=(float*)(shm+LDS_WS); float*fs=(float*)(shm+LDS_FS2);
  const float*src=logf+((long)b*SEQ+4*tid)*16+h;
  const float v0=src[0],v1=src[16],v2=src[32],v3=src[48]; const float p0=v0,p1=p0+v1,p2=p1+v2,p3=p2+v3;
  float inc=p3;
  #pragma unroll
  for(int o=1;o<64;o<<=1){ const float y=__shfl_up(inc,o); if(lane>=o)inc+=y; }
  if(lane==63)ws[wid]=inc;
  __syncthreads();
  float woff=0.f;
  #pragma unroll
  for(int w=0;w<8;++w){ const float x=ws[w]; if(w<wid)woff+=x; }
  const float ex=woff+inc-p3; const float L2E=-1.4426950408889634f;
  f32x4w o; o[0]=(ex+p0)*L2E;o[1]=(ex+p1)*L2E;o[2]=(ex+p2)*L2E;o[3]=(ex+p3)*L2E;
  *(f32x4w*)(fs+4*tid)=o;
  __syncthreads();
}
constexpr int ATTN_LDS_BYTES=LDS_BYTES;
struct AttnTensors { const bf16* Q; const bf16* K; const bf16* V; const bf16* G; bf16* O; const float* logf; };
struct AttnUnit { int bh; int qb; };
struct StaticOrder {
  int vcu;
  __device__ __forceinline__ explicit StaticOrder(int grid,int block):vcu((block%8)*(grid/8)+block/8){}
  __device__ __forceinline__ bool next(int i,AttnUnit&u)const{ if(i>=2||vcu>=BATCH*NHEAD*4)return false; const int s=vcu&3; u.bh=vcu>>2; u.qb=(i==0)?7-s:s; return true; }
  __device__ __forceinline__ void a_ready(const AttnUnit&)const{}
  __device__ __forceinline__ void done(const AttnUnit&)const{}
};
template<class Sched,int THRL=8> __device__ __forceinline__ void attn_phase(char*lds,const AttnTensors&T,const Sched&S){
  AttnUnit u;
  if(!S.next(0,u))return;
  bias_table(lds,T.logf,u.bh/NHEAD,u.bh%NHEAD);
  for(int i=0;S.next(i,u);++i){ S.a_ready(u); attn_unit<THRL>(u.bh/NHEAD,u.bh%NHEAD,u.qb,T.Q,T.K,T.V,T.G,T.O,lds); S.done(u); }
}
#undef SBAR
#undef WAIT_BAR
}

constexpr int NWAVES = 8;
constexpr int DMODEL = 2048, NB = 4, SEQ = 2048, MP = NB * SEQ, DB = 8, DS = 8, MS = DB * DS, MT = MP + MS;
constexpr int NH = 16, HD = 64, AW = 1024, PW = 1024, INC = 10256, NIN = 10240, FLC = 6144;
constexpr int PAGE = 128, NPG = 128, PBUF = 15;
constexpr float EPS = 1e-6f, LOG2E = 1.4426950408889634f, C2 = 0.125f * 1.4426950408889634f;
constexpr size_t O_YP = 0, O_YS = O_YP + (size_t)MP * DMODEL, O_KP = O_YS + (size_t)MS * DMODEL, O_VP = O_KP + (size_t)MP * AW, O_LFP = O_VP + (size_t)MP * AW,
                 O_PP = O_LFP + (size_t)MP * NH, O_KS = O_PP + (size_t)NB * PBUF * PW, O_VS = O_KS + (size_t)MS * AW, O_LFS = O_VS + (size_t)MS * AW, O_PS = O_LFS + (size_t)MS * NH,
                 O_END = O_PS + (size_t)DB * PBUF * PW;
constexpr size_t MiB = 1u << 20;
constexpr size_t WS_CTL = 0, CTL_ZERO_BYTES = 1 * MiB;
constexpr size_t WS_WIN = 2 * MiB, WS_WPM = 42 * MiB, WS_WUP = 43 * MiB, WS_WOUT = 51 * MiB;
constexpr size_t WS_XB = 60 * MiB, WS_RINV = 93 * MiB, WS_PSUM = 94 * MiB;
constexpr size_t WS_U = 95 * MiB, WS_GP = 112 * MiB, WS_Q = 129 * MiB, WS_KB = 146 * MiB, WS_VB = 163 * MiB, WS_GA = 180 * MiB, WS_D = 197 * MiB;
constexpr size_t WS_MA = 214 * MiB, WS_MB = 247 * MiB, WS_AB = 280 * MiB, WS_MG = 313 * MiB;
constexpr size_t WS_P32 = 346 * MiB, WS_PO = 410 * MiB, WS_PML = 418 * MiB, WS_END = 420 * MiB;
constexpr int CW_TMO = 0, CW_CODE = 1, CW_BAR = 4096;
constexpr int RING_OFF = 0, RING_BYTES = 131072;
constexpr int LDSCTL_OFF = 143360, MISC_OFF = LDSCTL_OFF + 320;
constexpr int LDS_BYTES = 147456;
static_assert(MISC_OFF + 128 <= LDS_BYTES, "LDS map");

#define GAS __attribute__((address_space(1)))
#define LAS __attribute__((address_space(3)))
typedef unsigned short bf16;
typedef unsigned v4u __attribute__((ext_vector_type(4)));
typedef float f32x4 __attribute__((ext_vector_type(4)));
typedef short bf16x8 __attribute__((ext_vector_type(8)));
typedef GAS unsigned gu32;
typedef GAS unsigned long long gu64;
#define RLX_AGENT __ATOMIC_RELAXED, __HIP_MEMORY_SCOPE_AGENT
#define LDS_WAIT() asm volatile("s_waitcnt lgkmcnt(0)" ::: "memory")
#define VM_WAIT() asm volatile("s_waitcnt vmcnt(0)" ::: "memory")
__device__ __forceinline__ unsigned long long rt() { return __builtin_amdgcn_s_memrealtime(); }
__device__ __forceinline__ unsigned f2bf(float f) { unsigned u = __builtin_bit_cast(unsigned, f); return (u + 0x7fffu + ((u >> 16) & 1u)) >> 16; }
__device__ __forceinline__ unsigned pk2(float lo, float hi) { return f2bf(lo) | (f2bf(hi) << 16); }

#define XB_TMO      128
#define XB_XCNT(j)  (256  + 64 * (j))
#define XB_XSUB(j)  (1280 + 64 * (j))
#define XB_XGEN(j)  (2304 + 64 * (j))
#define XB_TOP      3328
#define XB_TOPGEN   3392
#define XCD_BAR_WORDS 3456
#define XB_SPIN_CAP (1u << 18)

__device__ __forceinline__ unsigned xb_ld(unsigned* p)              { return __hip_atomic_load(p, __ATOMIC_RELAXED, __HIP_MEMORY_SCOPE_AGENT); }
__device__ __forceinline__ unsigned xb_add(unsigned* p, unsigned v) { return __hip_atomic_fetch_add(p, v, __ATOMIC_RELAXED, __HIP_MEMORY_SCOPE_AGENT); }
__device__ __forceinline__ unsigned xb_xcc_id() { return (unsigned)__builtin_amdgcn_s_getreg((3 << 11) | 20) & 0xFu; }
#define XB_SPIN(cond, bar) do { unsigned _sp = 0; while (cond) { __builtin_amdgcn_s_sleep(1); \
    if ((++_sp & 255u) == 0u) { if (xb_ld(&(bar)[XB_TMO])) break; if (_sp > XB_SPIN_CAP) { atomicAdd(&(bar)[XB_TMO], 1u); break; } } } } while (0)

struct XcdBarrier {
    unsigned* bar; unsigned x;
    volatile LAS unsigned* st;
};

__device__ __forceinline__ XcdBarrier xcd_barrier_post(unsigned* bar, volatile LAS unsigned* st) {
    XcdBarrier b; b.bar = bar; b.x = xb_xcc_id(); b.st = st;
    if (threadIdx.x == 0) (void)xb_add(&bar[XB_XCNT(b.x)], 1u);
    return b;
}
__device__ __forceinline__ void xcd_barrier_complete(unsigned* bar, unsigned x, unsigned& nloc, unsigned& nx) {
    const unsigned G = gridDim.x * gridDim.y * gridDim.z;
    unsigned sum, cnt, mine, sp = 0u;
    for (;;) {
        sum = 0u; cnt = 0u; mine = 0u;
#pragma unroll
        for (unsigned j = 0; j < 16; ++j) { const unsigned c = xb_ld(&bar[XB_XCNT(j)]); sum += c; cnt += (c > 0u) ? 1u : 0u; mine = (j == x) ? c : mine; }
        if (sum == G) break;
        __builtin_amdgcn_s_sleep(1);
        if ((++sp & 255u) == 0u) { if (xb_ld(&bar[XB_TMO])) break; if (sp > XB_SPIN_CAP) { atomicAdd(&bar[XB_TMO], 1u); break; } }
    }
    nloc = mine > 0u ? mine : 1u; nx = cnt > 0u ? cnt : 1u;
}

__device__ __forceinline__ void xcd_barrier(const XcdBarrier& b) {
    asm volatile("s_waitcnt vmcnt(0)" ::: "memory");
    __syncthreads();
    if (threadIdx.x == 0) {
        unsigned* bar = b.bar;
        __builtin_amdgcn_s_waitcnt(0);
        unsigned nloc = b.st[0], nx = b.st[1];
        if (nloc == 0u) { xcd_barrier_complete(bar, b.x, nloc, nx); b.st[0] = nloc; b.st[1] = nx; }
        const unsigned old = xb_add(&bar[XB_XSUB(b.x)], 1u);
        const unsigned gen = old / nloc;
        if (old + 1u == (gen + 1u) * nloc) {
            __builtin_amdgcn_fence(__ATOMIC_RELEASE, "agent");
            asm volatile("s_waitcnt vmcnt(0)" ::: "memory");
            const unsigned og = xb_add(&bar[XB_TOP], 1u);
            const unsigned tg = og / nx;
            if (og + 1u == (tg + 1u) * nx) xb_add(&bar[XB_TOPGEN], 1u);
            else XB_SPIN(xb_ld(&bar[XB_TOPGEN]) == tg, bar);
            __builtin_amdgcn_fence(__ATOMIC_ACQUIRE, "agent");
            xb_add(&bar[XB_XGEN(b.x)], 1u);
            asm volatile("s_waitcnt vmcnt(0)" ::: "memory");
        } else {
            XB_SPIN(xb_ld(&bar[XB_XGEN(b.x)]) == gen, bar);
            __builtin_amdgcn_fence(__ATOMIC_ACQUIRE, "agent");
            asm volatile("s_waitcnt vmcnt(0)" ::: "memory");
        }
    }
    __syncthreads();
}

struct Args { const float* in[17]; float* out; unsigned char* ws; };
struct Frame {
    LAS unsigned char* lds; volatile LAS unsigned* MISC; gu32* ctl;
    int wave, vcu, G;
    const float *xp, *xs, *cache_k, *cache_v, *cache_lf, *state_pool, *norm_gain, *w_in, *b_f, *qg, *kg, *w_pm, *pool_scale, *w_upp, *w_upa, *w_out; const int* page_table;
    float* out;
    unsigned char* ws;
};
__device__ __forceinline__ float wave_sum(float v) {
#pragma unroll
    for (int o = 1; o < 64; o <<= 1) v += __shfl_xor(v, o);
    return v;
}
__device__ __forceinline__ float wave_max(float v) {
#pragma unroll
    for (int o = 1; o < 64; o <<= 1) v = fmaxf(v, __shfl_xor(v, o));
    return v;
}
__device__ __forceinline__ float bf_lo(unsigned u) { return __uint_as_float(u << 16); }
__device__ __forceinline__ float bf_hi(unsigned u) { return __uint_as_float(u & 0xffff0000u); }
__device__ __forceinline__ unsigned pkbf(float lo, float hi) { return pg8::cvt_pk_bf16(lo, hi); }
__device__ __forceinline__ float sigmoidf_(float x) { return 1.0f / (1.0f + __expf(-x)); }
__device__ __forceinline__ float siluf_(float x) { return x / (1.0f + __expf(-x)); }
__device__ __forceinline__ float logsigmoidf_(float x) { return fminf(x, 0.f) - log1pf(expf(-fabsf(x))); }

__device__ __forceinline__ void p0_transpose_item(const float* W, int N, int src_n0, int k0, const float* gain, bf16* WT, int ldt, int dst_row0, LAS float* scr, int lane) {
#pragma unroll 8
    for (int i = 0; i < 32; ++i) { const int kk = 2 * i + (lane >> 5); float v = W[(size_t)(k0 + kk) * N + src_n0 + (lane & 31)]; if (gain) v *= gain[k0 + kk]; scr[kk * 33 + (lane & 31)] = v; }
    LDS_WAIT(); asm volatile("" ::: "memory");
    const int c = lane & 7;
#pragma unroll
    for (int j = 0; j < 4; ++j) { const int n = (lane >> 3) + 8 * j; const LAS float* s = scr + (8 * c) * 33 + n;
        v4u o; o.x = pkbf(s[0 * 33], s[1 * 33]); o.y = pkbf(s[2 * 33], s[3 * 33]); o.z = pkbf(s[4 * 33], s[5 * 33]); o.w = pkbf(s[6 * 33], s[7 * 33]);
        *(GAS v4u*)(WT + (size_t)(dst_row0 + n) * ldt + k0 + 8 * c) = o; }
    LDS_WAIT(); asm volatile("" ::: "memory");
}
__device__ __forceinline__ void p0_row(Frame& F, int m, const LAS unsigned* WF) {
    const int tid_ = tid_fresh(), lane_ = tid_ & 63;
    const float* xrow = (m < MP) ? F.xp + (size_t)m * DMODEL : F.xs + (size_t)(m - MP) * DMODEL;
    const GAS f32x4* xr = (const GAS f32x4*)xrow + lane_;
    f32x4 v[8]; float ss = 0.f;
#pragma unroll
    for (int j = 0; j < 8; ++j) { v[j] = xr[64 * j]; ss += (v[j].x * v[j].x + v[j].y * v[j].y) + (v[j].z * v[j].z + v[j].w * v[j].w); }
    ss = wave_sum(ss);
    const float rinv = 1.0f / sqrtf(ss * (1.0f / DMODEL) + EPS);
    GAS unsigned long long* o8 = (GAS unsigned long long*)(((bf16*)(F.ws + WS_XB)) + (size_t)m * DMODEL) + lane_;
    float acc[16];
#pragma unroll
    for (int h = 0; h < 16; ++h) acc[h] = 0.f;
    typedef __bf16 bf16x2_t __attribute__((ext_vector_type(2)));
    typedef unsigned u32x2 __attribute__((ext_vector_type(2)));
#pragma unroll
    for (int j = 0; j < 8; ++j) {
        const unsigned p0 = pkbf(v[j].x, v[j].y), p1 = pkbf(v[j].z, v[j].w);
        o8[64 * j] = (unsigned long long)p0 | ((unsigned long long)p1 << 32);
#pragma unroll
        for (int h = 0; h < 16; ++h) { const unsigned wx = WF[h * 1024 + 128 * j + 2 * lane_], wy = WF[h * 1024 + 128 * j + 2 * lane_ + 1];
            acc[h] = __builtin_amdgcn_fdot2_f32_bf16(__builtin_bit_cast(bf16x2_t, p0), __builtin_bit_cast(bf16x2_t, wx), acc[h], false);
            acc[h] = __builtin_amdgcn_fdot2_f32_bf16(__builtin_bit_cast(bf16x2_t, p1), __builtin_bit_cast(bf16x2_t, wy), acc[h], false); }
    }
#pragma unroll
    for (int st = 0; st < 4; ++st) { const int s = 32 >> st, half = 8 >> st; const bool up = (lane_ & s) != 0;
#pragma unroll
        for (int i = 0; i < half; ++i) { const float send = up ? acc[i] : acc[i + half]; const float keep = up ? acc[i + half] : acc[i]; acc[i] = keep + __shfl_xor(send, s); } }
    float t = acc[0]; t += __shfl_xor(t, 2); t += __shfl_xor(t, 1);
    if ((lane_ & 3) == 0) { const int h = ((lane_ >> 5) & 1) * 8 + ((lane_ >> 4) & 1) * 4 + ((lane_ >> 3) & 1) * 2 + ((lane_ >> 2) & 1);
        const float lf = logsigmoidf_(t * rinv + F.b_f[h]);
        if (m < MP) F.out[O_LFP + (size_t)m * NH + h] = lf; else F.out[O_LFS + (size_t)(m - MP) * NH + h] = lf; }
    if (lane_ == 0) ((float*)(F.ws + WS_RINV))[m] = rinv;
}
__device__ __forceinline__ void p0_prologue(Frame& F) {
    const int tid_ = tid_fresh(), lane_ = tid_ & 63;
    LAS unsigned* WF = (LAS unsigned*)(F.lds + RING_OFF);
    for (int idx = tid_; idx < 16 * 1024; idx += NWAVES * 64) { const int h = idx & 15, i = idx >> 4;
        const float a = F.w_in[(size_t)(2 * i) * INC + FLC + h] * F.norm_gain[2 * i], b = F.w_in[(size_t)(2 * i + 1) * INC + FLC + h] * F.norm_gain[2 * i + 1];
        WF[h * 1024 + i] = pkbf(a, b); }
    __syncthreads();
    LAS float* scr = (LAS float*)(F.lds + 65536 + F.wave * 8448);
    const int gw = F.vcu * NWAVES + F.wave, NGW = F.G * NWAVES;
    for (int m = gw; m < MT; m += NGW) p0_row(F, m, WF);
    for (int it = gw; it < DB * NPG; it += NGW) { const int phys = F.page_table[it]; const GAS f32x4* src = (const GAS f32x4*)(F.cache_lf + (size_t)phys * PAGE * NH) + lane_;
        f32x4 s = src[0];
#pragma unroll
        for (int i = 1; i < 8; ++i) s += src[64 * i];
#pragma unroll
        for (int o = 4; o < 64; o <<= 1) { s.x += __shfl_xor(s.x, o); s.y += __shfl_xor(s.y, o); s.z += __shfl_xor(s.z, o); s.w += __shfl_xor(s.w, o); }
        if (lane_ < 4) *(GAS f32x4*)(((float*)(F.ws + WS_PSUM)) + (size_t)it * NH + 4 * lane_) = s; }
    for (int it = gw; it < DB * 7; it += NGW) { const int b = it / 7, r = it % 7; const GAS f32x4* src = (const GAS f32x4*)(F.state_pool + (size_t)(b * PBUF + r + 8) * PW) + lane_;
        GAS f32x4* dst = (GAS f32x4*)(F.out + O_PS + (size_t)(b * PBUF + r) * PW) + lane_;
#pragma unroll
        for (int i = 0; i < 4; ++i) dst[64 * i] = src[64 * i]; }
    constexpr int I_IN = (DMODEL / 64) * (NIN / 32), I_PM = 4 * (256 / 64) * (256 / 32), I_UP = (1024 / 64) * (DMODEL / 32), I_OUT = (DMODEL / 64) * (DMODEL / 32);
    constexpr int NITEMS = I_IN + I_PM + 2 * I_UP + I_OUT;
    for (int it = gw; it < NITEMS; it += NGW) {
        int r = it;
        if (r < I_IN) { const int kb = r / (NIN / 32), nb = r % (NIN / 32), pn = nb >> 3, gi = nb & 7, a0 = 64 * (gi & 3) + 32 * (gi >> 2);
            p0_transpose_item(F.w_in, INC, 256 * pn + a0 + (pn >= 24 ? 16 : 0), 64 * kb, F.norm_gain, ((bf16*)(F.ws + WS_WIN)), DMODEL, 32 * nb, scr, lane_); continue; } r -= I_IN;
        if (r < I_PM) { const int g = r >> 5, q = r & 31, kb = q >> 3, nb = q & 7;
            p0_transpose_item(F.w_pm + (size_t)g * 65536, 256, 32 * nb, 64 * kb, nullptr, ((bf16*)(F.ws + WS_WPM)) + (size_t)g * 65536, 256, 32 * nb, scr, lane_); continue; } r -= I_PM;
        if (r < I_UP) { const int kb = r / (DMODEL / 32), nb = r % (DMODEL / 32); p0_transpose_item(F.w_upp, DMODEL, 32 * nb, 64 * kb, nullptr, ((bf16*)(F.ws + WS_WUP)), 1024, 32 * nb, scr, lane_); continue; } r -= I_UP;
        if (r < I_UP) { const int kb = r / (DMODEL / 32), nb = r % (DMODEL / 32); p0_transpose_item(F.w_upa, DMODEL, 32 * nb, 64 * kb, nullptr, ((bf16*)(F.ws + WS_WUP)) + (size_t)DMODEL * 1024, 1024, 32 * nb, scr, lane_); continue; } r -= I_UP;
        { const int kb = r / (DMODEL / 32), nb = r % (DMODEL / 32); p0_transpose_item(F.w_out, DMODEL, 32 * nb, 64 * kb, nullptr, ((bf16*)(F.ws + WS_WOUT)), DMODEL, 32 * nb, scr, lane_); }
    }
}

using pg8::Unit; using pg8::f32x4;
typedef unsigned u32x4 __attribute__((ext_vector_type(4)));
__device__ __forceinline__ void st8_bf16(bf16* p, f32x4 a, f32x4 b) { u32x4 w; w.x = pkbf(a[0], a[1]); w.y = pkbf(a[2], a[3]); w.z = pkbf(b[0], b[1]); w.w = pkbf(b[2], b[3]); *(GAS u32x4*)p = w; }
__device__ __forceinline__ void st8_f32(float* p, f32x4 a, f32x4 b) { *(GAS f32x4*)p = a; *(GAS f32x4*)(p + 4) = b; }
__device__ __forceinline__ void ld8_bf16(const bf16* p, f32x4& a, f32x4& b) { const u32x4 w = *(const GAS u32x4*)p; a = (f32x4){bf_lo(w.x), bf_hi(w.x), bf_lo(w.y), bf_hi(w.y)}; b = (f32x4){bf_lo(w.z), bf_hi(w.z), bf_lo(w.w), bf_hi(w.w)}; }

struct SchedIn {
    int G, c; const char* A; const char* B;
    __device__ __forceinline__ bool next(int i, Unit& u) const { if (!pg8::static_tile(i, G, c, MP / 256, NIN / 256, u.pm, u.pn)) return false; u.aux = 0;
        u.a = A + (size_t)u.pm * 256 * DMODEL * 2; u.b = B + (size_t)u.pn * 256 * DMODEL * 2; return true; }
    __device__ __forceinline__ void a_ready(const Unit&) const {} __device__ __forceinline__ void done(const Unit&) const {}
};
struct SchedPool {
    int G, c; const char* A; const char* B;
    __device__ __forceinline__ bool next(int i, Unit& u) const { const int L = i * G + c; if (L >= (MP / 256) * 4) return false; u.pm = L >> 2; u.pn = L & 3; u.aux = 0;
        u.a = A + ((size_t)u.pm * 256 * PW + 256 * u.pn) * 2; u.b = B + (size_t)u.pn * 65536 * 2; return true; }
    __device__ __forceinline__ void a_ready(const Unit&) const {} __device__ __forceinline__ void done(const Unit&) const {}
};
struct SchedUp {
    int G, c; const char* A; const char* B;
    __device__ __forceinline__ bool next(int i, Unit& u) const { if (i >= 2) return false; if (!pg8::static_tile(0, G, c, MP / 256, DMODEL / 256, u.pm, u.pn)) return false; u.aux = i;
        u.a = A + ((size_t)u.pm * 256 * DMODEL + 1024 * i) * 2; u.b = B + ((size_t)i * DMODEL * 1024 + (size_t)u.pn * 256 * 1024) * 2; return true; }
    __device__ __forceinline__ void a_ready(const Unit&) const {} __device__ __forceinline__ void done(const Unit&) const {}
};
struct SchedOut {
    int G, c; const char* A; const char* B;
    __device__ __forceinline__ bool next(int i, Unit& u) const { if (!pg8::static_tile(i, G, c, MP / 256, DMODEL / 256, u.pm, u.pn)) return false; u.aux = 0;
        u.a = A + (size_t)u.pm * 256 * DMODEL * 2; u.b = B + (size_t)u.pn * 256 * DMODEL * 2; return true; }
    __device__ __forceinline__ void a_ready(const Unit&) const {} __device__ __forceinline__ void done(const Unit&) const {}
};

struct EpiIn {
    static constexpr bool PERM = true, AFTER_DRAIN = false;
    const float* rinv; bf16 *U, *GP, *Q, *KB, *VB, *GA, *MA, *MB; float *kout, *vout, *pool; const float *qg, *kg;
    __device__ __forceinline__ void operator()(const f32x4 (&acc)[2][2][4][2], const Unit& u, int wr, int wc, int, int) const {
        const int l_ = tid_fresh() & 63, fr = l_ & 15, fq = l_ >> 4;
        const int pn = u.pn, region = pn < 24 ? (pn >> 2) : (pn < 32 ? 6 : 7);
        int row0 = u.pm * 256 + wr * 64 + fr; asm volatile("" : "+v"(row0));
        const int cb = (pn < 24 ? 256 * (pn & 3) : 256 * ((pn - 24) & 7)) + 64 * wc + 8 * fq;
        if (region == 2 || region == 3) {
            const float* gn = (region == 2) ? qg : kg; const float sc = (region == 2) ? C2 : 1.0f;
            f32x4 g0[2], g1[2];
#pragma unroll
            for (int bj = 0; bj < 2; ++bj) { g0[bj] = *(const GAS f32x4*)(gn + 32 * bj + 8 * fq) * sc; g1[bj] = *(const GAS f32x4*)(gn + 32 * bj + 8 * fq + 4) * sc; }
#pragma unroll
            for (int ai = 0; ai < 2; ++ai)
#pragma unroll
                for (int m = 0; m < 4; ++m) { const int row = row0 + ai * 128 + m * 16; const float rv = rinv[row];
                    f32x4 v[2][2]; float ss = 0.f;
#pragma unroll
                    for (int bj = 0; bj < 2; ++bj)
#pragma unroll
                        for (int n = 0; n < 2; ++n) { v[bj][n] = acc[ai][bj][m][n] * rv; const f32x4 x = v[bj][n]; ss += (x[0] * x[0] + x[1] * x[1]) + (x[2] * x[2] + x[3] * x[3]); }
                    ss += __shfl_xor(ss, 16); ss += __shfl_xor(ss, 32);
                    const float r = 1.0f / sqrtf(ss * (1.0f / 64.0f) + EPS);
#pragma unroll
                    for (int bj = 0; bj < 2; ++bj) { const f32x4 a = v[bj][0] * r * g0[bj], b = v[bj][1] * r * g1[bj]; const size_t off = (size_t)row * AW + cb + 32 * bj;
                        if (region == 2) st8_bf16(Q + off, a, b); else { st8_f32(kout + off, a, b); st8_bf16(KB + off, a, b); } } }
            return;
        }
#pragma unroll
        for (int ai = 0; ai < 2; ++ai)
#pragma unroll
            for (int m = 0; m < 4; ++m) { const int row = row0 + ai * 128 + m * 16; const float rv = rinv[row];
#pragma unroll
                for (int bj = 0; bj < 2; ++bj) { f32x4 a = acc[ai][bj][m][0] * rv, b = acc[ai][bj][m][1] * rv; const int col = cb + 32 * bj;
                    if (region == 0) { st8_bf16(U + (size_t)row * PW + col, a, b); const int t = row & (SEQ - 1); if (t >= SEQ - PBUF) st8_f32(pool + ((size_t)(row >> 11) * PBUF + (t - (SEQ - PBUF))) * PW + col, a, b); }
                    else if (region == 4) { st8_f32(vout + (size_t)row * AW + col, a, b); st8_bf16(VB + (size_t)row * AW + col, a, b); }
                    else if (region == 1 || region == 5) {
#pragma unroll
                        for (int e = 0; e < 4; ++e) { a[e] = siluf_(a[e]); b[e] = siluf_(b[e]); }
                        st8_bf16((region == 1 ? GP : GA) + (size_t)row * AW + col, a, b); }
                    else {
#pragma unroll
                        for (int e = 0; e < 4; ++e) { a[e] = sigmoidf_(a[e]); b[e] = sigmoidf_(b[e]); }
                        st8_bf16((region == 6 ? MA : MB) + (size_t)row * DMODEL + col, a, b); } } }
    }
};
struct EpiPool {
    static constexpr bool PERM = true, AFTER_DRAIN = false;
    const float* scale; const bf16* GP; bf16* AB;
    __device__ __forceinline__ void operator()(const f32x4 (&acc)[2][2][4][2], const Unit& u, int wr, int wc, int, int) const {
        const int l_ = tid_fresh() & 63, fr = l_ & 15, fq = l_ >> 4;
        int row0 = u.pm * 256 + wr * 64 + fr, c0 = u.pn * 256 + wc * 32 + 8 * fq; asm volatile("" : "+v"(row0), "+v"(c0));
        f32x4 s0[2], s1[2];
#pragma unroll
        for (int bj = 0; bj < 2; ++bj) { s0[bj] = *(const GAS f32x4*)(scale + c0 + 128 * bj); s1[bj] = *(const GAS f32x4*)(scale + c0 + 128 * bj + 4); }
#pragma unroll
        for (int ai = 0; ai < 2; ++ai)
#pragma unroll
            for (int m = 0; m < 4; ++m) { const int row = row0 + ai * 128 + m * 16;
#pragma unroll
                for (int bj = 0; bj < 2; ++bj) { const int col = c0 + 128 * bj; f32x4 ga, gb; ld8_bf16(GP + (size_t)row * PW + col, ga, gb);
                    st8_bf16(AB + (size_t)row * DMODEL + col, acc[ai][bj][m][0] * s0[bj] * ga, acc[ai][bj][m][1] * s1[bj] * gb); } }
    }
};
struct EpiUp {
    static constexpr bool PERM = true, AFTER_DRAIN = false;
    const bf16 *MA, *MB; float* P32; bf16* MG;
    __device__ __forceinline__ void operator()(const f32x4 (&acc)[2][2][4][2], const Unit& u, int wr, int wc, int, int) const {
        const int l_ = tid_fresh() & 63, fr = l_ & 15, fq = l_ >> 4;
        int row0 = u.pm * 256 + wr * 64 + fr, c0 = u.pn * 256 + wc * 32 + 8 * fq; asm volatile("" : "+v"(row0), "+v"(c0));
#pragma unroll
        for (int ai = 0; ai < 2; ++ai)
#pragma unroll
            for (int m = 0; m < 4; ++m) { const int row = row0 + ai * 128 + m * 16;
#pragma unroll
                for (int bj = 0; bj < 2; ++bj) { const size_t off = (size_t)row * DMODEL + c0 + 128 * bj; f32x4 ga, gb;
                    if (u.aux == 0) { ld8_bf16(MA + off, ga, gb); st8_f32(P32 + off, acc[ai][bj][m][0] * ga, acc[ai][bj][m][1] * gb); }
                    else { ld8_bf16(MB + off, ga, gb); const f32x4 pa = *(const GAS f32x4*)(P32 + off), pb = *(const GAS f32x4*)(P32 + off + 4);
                        st8_bf16(MG + off, pa + acc[ai][bj][m][0] * ga, pb + acc[ai][bj][m][1] * gb); } } }
    }
};
struct EpiOut {
    static constexpr bool PERM = true, AFTER_DRAIN = false;
    const float* x; float* y;
    __device__ __forceinline__ void operator()(const f32x4 (&acc)[2][2][4][2], const Unit& u, int wr, int wc, int, int) const {
        const int l_ = tid_fresh() & 63, fr = l_ & 15, fq = l_ >> 4;
        int row0 = u.pm * 256 + wr * 64 + fr, c0 = u.pn * 256 + wc * 32 + 8 * fq; asm volatile("" : "+v"(row0), "+v"(c0));
#pragma unroll
        for (int ai = 0; ai < 2; ++ai)
#pragma unroll
            for (int m = 0; m < 4; ++m) { const int row = row0 + ai * 128 + m * 16;
#pragma unroll
                for (int bj = 0; bj < 2; ++bj) { const size_t off = (size_t)row * DMODEL + c0 + 128 * bj;
                    const f32x4 xa = *(const GAS f32x4*)(x + off), xb = *(const GAS f32x4*)(x + off + 4);
                    st8_f32(y + off, xa + acc[ai][bj][m][0], xb + acc[ai][bj][m][1]); } }
    }
};

constexpr int SK_RED = 0, SK_T0 = 16384, SK_T1 = 16384 + 17408, SK_PITCH = 68;
template <class BRow> __device__ __forceinline__ void skinny_mma(const bf16* A, int lda, int K, int ldb, const BRow& brow, LAS unsigned char* lds, int tile_off, int wave, int lane) {
    const int nb = wave & 3, kh = wave >> 2, r = lane & 15, g = lane >> 4;
    const GAS bf16* bp = (const GAS bf16*)brow(nb) + (size_t)r * ldb + kh * (K / 2) + 8 * g;
    const GAS bf16* ap = (const GAS bf16*)A + (size_t)r * lda + kh * (K / 2) + 8 * g;
    f32x4 acc[4];
#pragma unroll
    for (int mb = 0; mb < 4; ++mb) acc[mb] = (f32x4){0.f, 0.f, 0.f, 0.f};
    const int nks = K / 64;
#pragma unroll 4
    for (int ks = 0; ks < nks; ++ks) { const bf16x8 bf = *(const GAS bf16x8*)(bp + 32 * ks);
#pragma unroll
        for (int mb = 0; mb < 4; ++mb) { const bf16x8 af = *(const GAS bf16x8*)(ap + (size_t)(16 * mb) * lda + 32 * ks); acc[mb] = __builtin_amdgcn_mfma_f32_16x16x32_bf16(af, bf, acc[mb], 0, 0, 0); } }
    LAS f32x4* red = (LAS f32x4*)(lds + SK_RED); LAS float* tile = (LAS float*)(lds + tile_off);
    if (kh == 1) {
#pragma unroll
        for (int mb = 0; mb < 4; ++mb) red[(nb * 4 + mb) * 64 + lane] = acc[mb]; }
    __syncthreads();
    if (kh == 0) {
#pragma unroll
        for (int mb = 0; mb < 4; ++mb) { const f32x4 o = acc[mb] + red[(nb * 4 + mb) * 64 + lane];
#pragma unroll
            for (int i = 0; i < 4; ++i) tile[(16 * mb + 4 * g + i) * SK_PITCH + 16 * nb + r] = o[i]; } }
    __syncthreads();
}
__device__ __forceinline__ void tile_ld8(const LAS unsigned char* lds, int tile_off, int row, int cg, f32x4& a, f32x4& b) {
    const LAS f32x4* p = (const LAS f32x4*)(lds + tile_off + (row * SK_PITCH + 8 * cg) * 4); a = p[0]; b = p[1]; }

__device__ __forceinline__ void sample_in_unit(Frame& F, int su) {
    const int tid_ = tid_fresh(), lane_ = tid_ & 63;
    const int pn = su >> 2, wcu = su & 3, region = su >> 4;
    const bf16* Bbase = ((bf16*)(F.ws + WS_WIN)) + (size_t)(256 * pn + 32 * wcu) * DMODEL;
    auto brow = [&](int nb) { return Bbase + (size_t)(128 * (nb >> 1) + 16 * (nb & 1)) * DMODEL; };
    skinny_mma(((bf16*)(F.ws + WS_XB)) + (size_t)MP * DMODEL, DMODEL, DMODEL, DMODEL, brow, F.lds, SK_T0, F.wave, lane_);
    const int srow = tid_ >> 3, cg = tid_ & 7, row = MP + srow; f32x4 a, b; tile_ld8(F.lds, SK_T0, srow, cg, a, b);
    const float rv = ((float*)(F.ws + WS_RINV))[row]; a = a * rv; b = b * rv;
    const int col = 64 * (su & 15) + 8 * cg;
    if (region == 0) { st8_bf16(((bf16*)(F.ws + WS_U)) + (size_t)row * PW + col, a, b); st8_f32(F.out + O_PS + ((size_t)(srow >> 3) * PBUF + 7 + (srow & 7)) * PW + col, a, b); }
    else if (region == 1 || region == 5) {
#pragma unroll
        for (int e = 0; e < 4; ++e) { a[e] = siluf_(a[e]); b[e] = siluf_(b[e]); }
        st8_bf16((region == 1 ? ((bf16*)(F.ws + WS_GP)) : ((bf16*)(F.ws + WS_GA))) + (size_t)row * AW + col, a, b); }
    else if (region == 2 || region == 3) {
        float ss = (a[0] * a[0] + a[1] * a[1]) + (a[2] * a[2] + a[3] * a[3]) + (b[0] * b[0] + b[1] * b[1]) + (b[2] * b[2] + b[3] * b[3]);
        ss += __shfl_xor(ss, 1); ss += __shfl_xor(ss, 2); ss += __shfl_xor(ss, 4);
        const float r = 1.0f / sqrtf(ss * (1.0f / 64.0f) + EPS); const float* gn = (region == 2) ? F.qg : F.kg; const float sc = (region == 2) ? C2 : 1.0f;
        const f32x4 g0 = *(const GAS f32x4*)(gn + 8 * cg), g1 = *(const GAS f32x4*)(gn + 8 * cg + 4);
        a = a * r * g0 * sc; b = b * r * g1 * sc;
        if (region == 2) st8_bf16(((bf16*)(F.ws + WS_Q)) + (size_t)row * AW + col, a, b); else { st8_f32(F.out + O_KS + (size_t)srow * AW + col, a, b); st8_bf16(((bf16*)(F.ws + WS_KB)) + (size_t)row * AW + col, a, b); } }
    else if (region == 4) { st8_f32(F.out + O_VS + (size_t)srow * AW + col, a, b); st8_bf16(((bf16*)(F.ws + WS_VB)) + (size_t)row * AW + col, a, b); }
    else { const int col2 = 64 * ((su - 96) & 31) + 8 * cg;
#pragma unroll
        for (int e = 0; e < 4; ++e) { a[e] = sigmoidf_(a[e]); b[e] = sigmoidf_(b[e]); }
        st8_bf16((su < 128 ? ((bf16*)(F.ws + WS_MA)) : ((bf16*)(F.ws + WS_MB))) + (size_t)row * DMODEL + col2, a, b); }
    __syncthreads();
}
__device__ __forceinline__ void sample_pool_unit(Frame& F, int j) {
    const int tid_ = tid_fresh(), lane_ = tid_ & 63;
    const int g = j >> 2, q4 = j & 3; const bf16* Bbase = ((bf16*)(F.ws + WS_WPM)) + (size_t)g * 65536 + (size_t)(64 * q4) * 256;
    auto brow = [&](int nb) { return Bbase + (size_t)(16 * nb) * 256; };
    skinny_mma(((bf16*)(F.ws + WS_D)) + (size_t)MP * PW + 256 * g, PW, 256, 256, brow, F.lds, SK_T0, F.wave, lane_);
    const int srow = tid_ >> 3, cg = tid_ & 7, row = MP + srow, col = 256 * g + 64 * q4 + 8 * cg; f32x4 a, b, ga, gb; tile_ld8(F.lds, SK_T0, srow, cg, a, b);
    const f32x4 s0 = *(const GAS f32x4*)(F.pool_scale + col), s1 = *(const GAS f32x4*)(F.pool_scale + col + 4); ld8_bf16(((bf16*)(F.ws + WS_GP)) + (size_t)row * PW + col, ga, gb);
    st8_bf16(((bf16*)(F.ws + WS_AB)) + (size_t)row * DMODEL + col, a * s0 * ga, b * s1 * gb);
    __syncthreads();
}
__device__ __forceinline__ void sample_up_unit(Frame& F, int j) {
    const int tid_ = tid_fresh(), lane_ = tid_ & 63;
    const bf16* B0 = ((bf16*)(F.ws + WS_WUP)) + (size_t)(64 * j) * 1024; const bf16* B1 = B0 + (size_t)DMODEL * 1024;
    auto brow0 = [&](int nb) { return B0 + (size_t)(16 * nb) * 1024; }; auto brow1 = [&](int nb) { return B1 + (size_t)(16 * nb) * 1024; };
    skinny_mma(((bf16*)(F.ws + WS_AB)) + (size_t)MP * DMODEL, DMODEL, 1024, 1024, brow0, F.lds, SK_T0, F.wave, lane_);
    skinny_mma(((bf16*)(F.ws + WS_AB)) + (size_t)MP * DMODEL + 1024, DMODEL, 1024, 1024, brow1, F.lds, SK_T1, F.wave, lane_);
    const int srow = tid_ >> 3, cg = tid_ & 7, row = MP + srow, col = 64 * j + 8 * cg; f32x4 a, b, c, d, ma, mb2, na, nb2;
    tile_ld8(F.lds, SK_T0, srow, cg, a, b); tile_ld8(F.lds, SK_T1, srow, cg, c, d);
    ld8_bf16(((bf16*)(F.ws + WS_MA)) + (size_t)row * DMODEL + col, ma, mb2); ld8_bf16(((bf16*)(F.ws + WS_MB)) + (size_t)row * DMODEL + col, na, nb2);
    st8_bf16(((bf16*)(F.ws + WS_MG)) + (size_t)row * DMODEL + col, a * ma + c * na, b * mb2 + d * nb2);
    __syncthreads();
}
__device__ __forceinline__ void sample_out_unit(Frame& F, int j) {
    const int tid_ = tid_fresh(), lane_ = tid_ & 63;
    const bf16* B0 = ((bf16*)(F.ws + WS_WOUT)) + (size_t)(64 * j) * DMODEL; auto brow = [&](int nb) { return B0 + (size_t)(16 * nb) * DMODEL; };
    skinny_mma(((bf16*)(F.ws + WS_MG)) + (size_t)MP * DMODEL, DMODEL, DMODEL, DMODEL, brow, F.lds, SK_T0, F.wave, lane_);
    const int srow = tid_ >> 3, cg = tid_ & 7, col = 64 * j + 8 * cg; f32x4 a, b; tile_ld8(F.lds, SK_T0, srow, cg, a, b);
    const f32x4 xa = *(const GAS f32x4*)(F.xs + (size_t)srow * DMODEL + col), xb = *(const GAS f32x4*)(F.xs + (size_t)srow * DMODEL + col + 4);
    st8_f32(F.out + O_YS + (size_t)srow * DMODEL + col, xa + a, xb + b);
    __syncthreads();
}

__device__ __forceinline__ void pool_diff(Frame& F) {
    const int tid_ = tid_fresh(), lane_ = tid_ & 63;
    const int gt = F.vcu * NWAVES * 64 + tid_, NT = F.G * NWAVES * 64;
    for (int idx = gt; idx < MT * 128; idx += NT) { const int row = idx >> 7, c0 = (idx & 127) * 8, w = 2 << (c0 >> 8);
        f32x4 sa, sb, ua, ub; ld8_bf16(((bf16*)(F.ws + WS_U)) + (size_t)row * PW + c0, ua, ub); sa = ua; sb = ub; float inv;
        if (row < MP) { const int t = row & (SEQ - 1), nw = (t + 1 < w) ? t + 1 : w;
            for (int j = 1; j < nw; ++j) { f32x4 a, b; ld8_bf16(((bf16*)(F.ws + WS_U)) + (size_t)(row - j) * PW + c0, a, b); sa += a; sb += b; }
            inv = 1.0f / (float)nw; }
        else { const int sr = row - MP, b8 = sr >> 3, i = sr & 7;
            for (int j = 1; j < w; ++j) { const int zi = PBUF + i - j; f32x4 a, b;
                if (zi >= PBUF) ld8_bf16(((bf16*)(F.ws + WS_U)) + (size_t)(MP + b8 * DS + zi - PBUF) * PW + c0, a, b);
                else { const float* sp = F.state_pool + ((size_t)b8 * PBUF + zi) * PW + c0; a = *(const GAS f32x4*)sp; b = *(const GAS f32x4*)(sp + 4); }
                sa += a; sb += b; }
            inv = 1.0f / (float)w; }
        st8_bf16(((bf16*)(F.ws + WS_D)) + (size_t)row * PW + c0, sa * inv - ua, sb * inv - ub); }
}

constexpr float NEGBIG = -1.0e30f;
__device__ __forceinline__ void decode_partials(Frame& F) {
    const int tid_ = tid_fresh(), lane_ = tid_ & 63;
    const int c = F.vcu; if (c >= DB * 32) return;
    const int b = c >> 5, sp = c & 31, pg0 = 4 * sp, lane = lane_, n = lane & 15, g = lane >> 4, w = F.wave;
    LAS float* btab = (LAS float*)(F.lds + w * 4096);
    int phys[4];
#pragma unroll
    for (int p = 0; p < 4; ++p) phys[p] = __builtin_amdgcn_readfirstlane(F.page_table[b * NPG + pg0 + p]);
    typedef unsigned u32x2 __attribute__((ext_vector_type(2)));
    bf16x8 qf[2][2];
#pragma unroll
    for (int hh = 0; hh < 2; ++hh) { const int h = w + 8 * hh;
        const float* ps = ((float*)(F.ws + WS_PSUM)) + (size_t)b * NPG * NH + h; float later = 0.f;
        { const int p0 = lane, p1 = lane + 64; const float x0 = (p0 >= pg0 + 4) ? ps[(size_t)p0 * NH] : 0.f, x1 = (p1 >= pg0 + 4) ? ps[(size_t)p1 * NH] : 0.f; later = wave_sum(x0 + x1); }
#pragma unroll
        for (int p = 3; p >= 0; --p) { const float* lf = F.cache_lf + (size_t)phys[p] * PAGE * NH + h; const float a = lf[(size_t)(2 * lane) * NH], bq = lf[(size_t)(2 * lane + 1) * NH];
            float inc = a + bq;
#pragma unroll
            for (int o = 1; o < 64; o <<= 1) { const float y = __shfl_down(inc, o); if (lane + o < 64) inc += y; }
            const float ex = inc - (a + bq);
            btab[(p * 2 + hh) * 128 + 2 * lane] = (later + ex + bq) * LOG2E; btab[(p * 2 + hh) * 128 + 2 * lane + 1] = (later + ex) * LOG2E;
            later += __shfl(inc, 0); }
        const bf16* qrow = ((bf16*)(F.ws + WS_Q)) + (size_t)(MP + b * DS + (n & 7)) * AW + h * HD;
#pragma unroll
        for (int half = 0; half < 2; ++half) { u32x2 lo = *(const GAS u32x2*)(qrow + 32 * half + 4 * g), hi2 = *(const GAS u32x2*)(qrow + 32 * half + 16 + 4 * g);
            if (n >= 8) { lo = (u32x2){0u, 0u}; hi2 = (u32x2){0u, 0u}; }
            qf[hh][half] = __builtin_bit_cast(bf16x8, (u32x4){lo.x, lo.y, hi2.x, hi2.y}); }
    }
    LDS_WAIT();
    float mrun[2] = {NEGBIG, NEGBIG}, lrun[2] = {0.f, 0.f}; f32x4 o[2][4];
#pragma unroll
    for (int hh = 0; hh < 2; ++hh)
#pragma unroll
        for (int mb = 0; mb < 4; ++mb) o[hh][mb] = (f32x4){0.f, 0.f, 0.f, 0.f};
#pragma unroll
    for (int hh = 0; hh < 2; ++hh) { const int h = w + 8 * hh;
        for (int p = 0; p < 4; ++p) { const float* kp = F.cache_k + ((size_t)phys[p] * PAGE * NH + h) * HD; const float* vp = F.cache_v + ((size_t)phys[p] * PAGE * NH + h) * HD;
            const LAS float* bt = btab + (p * 2 + hh) * 128;
#pragma unroll 2
            for (int blk = 0; blk < 4; ++blk) { const int j0 = 32 * blk;
                const GAS f32x4* ka = (const GAS f32x4*)(kp + (size_t)(j0 + n) * (NH * HD) + 4 * g); const GAS f32x4* kb = (const GAS f32x4*)(kp + (size_t)(j0 + 16 + n) * (NH * HD) + 4 * g);
                f32x4 kA[4], kB[4];
#pragma unroll
                for (int i = 0; i < 4; ++i) { kA[i] = ka[4 * i]; kB[i] = kb[4 * i]; }
                float vv[4][8];
#pragma unroll
                for (int mb = 0; mb < 4; ++mb)
#pragma unroll
                    for (int j = 0; j < 8; ++j) { const int tok = j0 + ((j < 4) ? 4 * g + j : 16 + 4 * g + (j - 4)); vv[mb][j] = *(const GAS float*)(vp + (size_t)tok * (NH * HD) + 16 * mb + n); }
                f32x4 sA = (f32x4){0.f, 0.f, 0.f, 0.f}, sB = sA;
#pragma unroll
                for (int half = 0; half < 2; ++half) {
                    const bf16x8 fa = __builtin_bit_cast(bf16x8, (u32x4){pkbf(kA[2 * half][0], kA[2 * half][1]), pkbf(kA[2 * half][2], kA[2 * half][3]), pkbf(kA[2 * half + 1][0], kA[2 * half + 1][1]), pkbf(kA[2 * half + 1][2], kA[2 * half + 1][3])});
                    const bf16x8 fb = __builtin_bit_cast(bf16x8, (u32x4){pkbf(kB[2 * half][0], kB[2 * half][1]), pkbf(kB[2 * half][2], kB[2 * half][3]), pkbf(kB[2 * half + 1][0], kB[2 * half + 1][1]), pkbf(kB[2 * half + 1][2], kB[2 * half + 1][3])});
                    sA = __builtin_amdgcn_mfma_f32_16x16x32_bf16(fa, qf[hh][half], sA, 0, 0, 0); sB = __builtin_amdgcn_mfma_f32_16x16x32_bf16(fb, qf[hh][half], sB, 0, 0, 0); }
                const f32x4 bA = *(const LAS f32x4*)(bt + j0 + 4 * g), bB = *(const LAS f32x4*)(bt + j0 + 16 + 4 * g);
                sA += bA; sB += bB;
                float bm = fmaxf(fmaxf(fmaxf(sA[0], sA[1]), fmaxf(sA[2], sA[3])), fmaxf(fmaxf(sB[0], sB[1]), fmaxf(sB[2], sB[3])));
                bm = fmaxf(bm, __shfl_xor(bm, 16)); bm = fmaxf(bm, __shfl_xor(bm, 32));
                const float mnew = fmaxf(mrun[hh], bm), alpha = __builtin_amdgcn_exp2f(mrun[hh] - mnew); mrun[hh] = mnew;
                float pa[4], pb[4], psum = 0.f;
#pragma unroll
                for (int i = 0; i < 4; ++i) { pa[i] = __builtin_amdgcn_exp2f(sA[i] - mnew); pb[i] = __builtin_amdgcn_exp2f(sB[i] - mnew); psum += pa[i] + pb[i]; }
                lrun[hh] = lrun[hh] * alpha + psum;
                const bf16x8 pf = __builtin_bit_cast(bf16x8, (u32x4){pkbf(pa[0], pa[1]), pkbf(pa[2], pa[3]), pkbf(pb[0], pb[1]), pkbf(pb[2], pb[3])});
#pragma unroll
                for (int mb = 0; mb < 4; ++mb) { const bf16x8 vf = __builtin_bit_cast(bf16x8, (u32x4){pkbf(vv[mb][0], vv[mb][1]), pkbf(vv[mb][2], vv[mb][3]), pkbf(vv[mb][4], vv[mb][5]), pkbf(vv[mb][6], vv[mb][7])});
                    o[hh][mb] = o[hh][mb] * alpha; o[hh][mb] = __builtin_amdgcn_mfma_f32_16x16x32_bf16(vf, pf, o[hh][mb], 0, 0, 0); }
            }
        }
    }
#pragma unroll
    for (int hh = 0; hh < 2; ++hh) { const int h = w + 8 * hh; float l = lrun[hh]; l += __shfl_xor(l, 16); l += __shfl_xor(l, 32);
        if (n < 8) { const size_t rec = ((size_t)(b * NH + h) * 32 + sp) * 8 + n;
            if (g == 0) { ((float*)(F.ws + WS_PML))[rec * 2] = mrun[hh]; ((float*)(F.ws + WS_PML))[rec * 2 + 1] = l; }
#pragma unroll
            for (int mb = 0; mb < 4; ++mb) *(GAS f32x4*)(((float*)(F.ws + WS_PO)) + rec * 64 + 16 * mb + 4 * g) = o[hh][mb]; } }
}
__device__ __forceinline__ void decode_combine(Frame& F, int bh) {
    const int tid_ = tid_fresh(), lane_ = tid_ & 63;
    const int b = bh >> 4, h = bh & 15, lane = lane_;
    float fn[8]; { float run = 0.f;
#pragma unroll
        for (int i = 0; i < 8; ++i) { run += F.out[O_LFS + (size_t)(b * DS + i) * NH + h]; fn[i] = run; } }
    float kd[8], vd[8];
#pragma unroll
    for (int i = 0; i < 8; ++i) { kd[i] = __uint_as_float((unsigned)((bf16*)(F.ws + WS_KB))[(size_t)(MP + b * DS + i) * AW + h * HD + lane] << 16); vd[i] = __uint_as_float((unsigned)((bf16*)(F.ws + WS_VB))[(size_t)(MP + b * DS + i) * AW + h * HD + lane] << 16); }
    const size_t rec0 = (size_t)bh * 32 * 8;
    for (int q = 0; q < 8; ++q) {
        const float qd = __uint_as_float((unsigned)((bf16*)(F.ws + WS_Q))[(size_t)(MP + b * DS + q) * AW + h * HD + lane] << 16);
        float xs[8];
#pragma unroll
        for (int s = 0; s < 8; ++s) xs[s] = (s <= q) ? wave_sum(qd * kd[s]) - fn[s] * LOG2E : NEGBIG;
        const float pm = (lane < 32) ? ((float*)(F.ws + WS_PML))[(rec0 + (size_t)lane * 8 + q) * 2] : NEGBIG, pl = (lane < 32) ? ((float*)(F.ws + WS_PML))[(rec0 + (size_t)lane * 8 + q) * 2 + 1] : 0.f;
        float mt = wave_max(pm);
#pragma unroll
        for (int s = 0; s < 8; ++s) mt = fmaxf(mt, xs[s]);
        const float sc = __builtin_amdgcn_exp2f(pm - mt);
        float lt = wave_sum(pl * sc), od = 0.f;
#pragma unroll
        for (int s = 0; s < 8; ++s) { const float p = (s <= q) ? __builtin_amdgcn_exp2f(xs[s] - mt) : 0.f; lt += p; od += p * vd[s]; }
        for (int s = 0; s < 32; ++s) od += __shfl(sc, s) * ((float*)(F.ws + WS_PO))[(rec0 + (size_t)s * 8 + q) * 64 + lane];
        const size_t row = MP + b * DS + q; const float gate = __uint_as_float((unsigned)((bf16*)(F.ws + WS_GA))[row * AW + h * HD + lane] << 16);
        const float r = od / lt * gate;
        const unsigned short hb = (unsigned short)(pkbf(r, r) & 0xffffu);
        ((bf16*)(F.ws + WS_AB))[row * DMODEL + 1024 + h * HD + lane] = hb;
    }
}
#ifdef DIAG
__device__ __forceinline__ float diag_rinv(const float* xrow, int lane) { float ss = 0.f; for (int k = lane; k < DMODEL; k += 64) ss += xrow[k] * xrow[k]; ss = wave_sum(ss); return 1.0f / sqrtf(ss * (1.0f / DMODEL) + EPS); }
__device__ __forceinline__ float diag_proj(Frame& F, const float* xrow, int col0, int lane, int ncol) { float acc = 0.f; if (lane < ncol) for (int k = 0; k < DMODEL; ++k) acc += xrow[k] * F.norm_gain[k] * F.w_in[(size_t)k * INC + col0 + lane]; return acc; }
__device__ __forceinline__ bool diag_cmp(float ref, float got, int lane, int ncol) { float d = (lane < ncol) ? (ref - got) * (ref - got) : 0.f, r = (lane < ncol) ? ref * ref : 0.f; d = wave_sum(d); r = wave_sum(r); return !(d <= 1e-3f * r + 1e-12f); }
__device__ __forceinline__ void diag_phase(Frame& F) {
    if (blockIdx.x != 0) return;
    const int tid_ = tid_fresh(), lane = tid_ & 63, w = F.wave;
    const int rows[3] = {0, 3000, 8191}, heads[3] = {0, 9, 15}, srows[3] = {0, 37, 63};
    bool bad[8] = {false, false, false, false, false, false, false, false};
    for (int ci = w; ci < 9; ci += 8) { const int ri = ci / 3, hi = ci % 3, h = heads[hi];
        { const int row = rows[ri]; const float* xr = F.xp + (size_t)row * DMODEL; const float r = diag_rinv(xr, lane);
            float kq = diag_proj(F, xr, 3072 + 64 * h, lane, 64) * r; float ss = wave_sum(kq * kq); kq = kq / sqrtf(ss * (1.0f / 64.0f) + EPS) * F.kg[lane];
            bad[0] |= diag_cmp(kq, F.out[O_KP + (size_t)row * AW + 64 * h + lane], lane, 64);
            const float vv = diag_proj(F, xr, 4096 + 64 * h, lane, 64) * r; bad[1] |= diag_cmp(vv, F.out[O_VP + (size_t)row * AW + 64 * h + lane], lane, 64);
            float fl = diag_proj(F, xr, FLC, lane, 16) * r; fl = (lane < 16) ? logsigmoidf_(fl + F.b_f[lane & 15]) : 0.f; bad[2] |= diag_cmp(fl, (lane < 16) ? F.out[O_LFP + (size_t)row * NH + lane] : 0.f, lane, 16);
            const int b = ri, j = 3 + 4 * hi, prow = b * SEQ + (SEQ - PBUF) + j; const float* xq = F.xp + (size_t)prow * DMODEL; const float r2 = diag_rinv(xq, lane);
            const float uu = diag_proj(F, xq, 64 * h, lane, 64) * r2; bad[3] |= diag_cmp(uu, F.out[O_PP + ((size_t)b * PBUF + j) * PW + 64 * h + lane], lane, 64); }
        { const int sr = srows[ri]; const float* xr = F.xs + (size_t)sr * DMODEL; const float r = diag_rinv(xr, lane);
            float kq = diag_proj(F, xr, 3072 + 64 * h, lane, 64) * r; float ss = wave_sum(kq * kq); kq = kq / sqrtf(ss * (1.0f / 64.0f) + EPS) * F.kg[lane];
            bad[4] |= diag_cmp(kq, F.out[O_KS + (size_t)sr * AW + 64 * h + lane], lane, 64);
            const float vv = diag_proj(F, xr, 4096 + 64 * h, lane, 64) * r; bad[5] |= diag_cmp(vv, F.out[O_VS + (size_t)sr * AW + 64 * h + lane], lane, 64);
            float fl = diag_proj(F, xr, FLC, lane, 16) * r; fl = (lane < 16) ? logsigmoidf_(fl + F.b_f[lane & 15]) : 0.f; bad[6] |= diag_cmp(fl, (lane < 16) ? F.out[O_LFS + (size_t)sr * NH + lane] : 0.f, lane, 16);
            const int b = sr >> 3, i = sr & 7; const float uu = diag_proj(F, xr, 64 * h, lane, 64) * r; bad[4] |= diag_cmp(uu, F.out[O_PS + ((size_t)b * PBUF + 7 + i) * PW + 64 * h + lane], lane, 64);
            const int r7 = hi * 3; bad[7] |= diag_cmp(F.state_pool[((size_t)b * PBUF + 8 + r7) * PW + 64 * h + lane], F.out[O_PS + ((size_t)b * PBUF + r7) * PW + 64 * h + lane], lane, 64); } }
    LAS unsigned* acc = (LAS unsigned*)(F.lds + 1024);
    if (tid_ == 0) *acc = 0u;
    __syncthreads();
    unsigned m = (bad[0] ? 1u : 0u) | (bad[1] ? 2u : 0u) | (bad[2] ? 4u : 0u) | (bad[3] ? 8u : 0u) | ((bad[4] || bad[5]) ? 16u : 0u) | ((bad[6] || bad[7]) ? 32u : 0u);
    if (lane == 0) atomicOr((unsigned*)acc, m);
    __syncthreads();
    if (tid_ == 0) F.out[O_YP] = 1.0e4f * (float)(1u + *acc);
}
#endif

__global__ void __launch_bounds__(NWAVES * 64, 2) mega_fwd(Args args) {
    extern __shared__ __attribute__((aligned(16))) unsigned char lds[];
    Frame F;
    F.lds = (LAS unsigned char*)lds;
    F.MISC = (volatile LAS unsigned*)(F.lds + MISC_OFF);
    F.wave = __builtin_amdgcn_readfirstlane((int)threadIdx.x >> 6);
    F.G = gridDim.x; { const int bx = blockIdx.x; F.vcu = (F.G % 8 == 0) ? (bx % 8) * (F.G / 8) + bx / 8 : bx; }
    unsigned char* ws = args.ws;
    F.ctl = (gu32*)(ws + WS_CTL);
    F.xp = args.in[0]; F.xs = args.in[1]; F.cache_k = args.in[2]; F.cache_v = args.in[3]; F.cache_lf = args.in[4]; F.state_pool = args.in[5]; F.page_table = (const int*)args.in[6];
    F.norm_gain = args.in[7]; F.w_in = args.in[8]; F.b_f = args.in[9]; F.qg = args.in[10]; F.kg = args.in[11]; F.w_pm = args.in[12]; F.pool_scale = args.in[13];
    F.w_upp = args.in[14]; F.w_upa = args.in[15]; F.w_out = args.in[16]; F.out = args.out;
    F.ws = ws;
    for (int u = threadIdx.x; u < (LDS_BYTES - LDSCTL_OFF) / 4; u += NWAVES * 64) ((LAS unsigned*)(F.lds + LDSCTL_OFF))[u] = 0u;
    __syncthreads();
    XcdBarrier bar = xcd_barrier_post((unsigned*)(F.ctl + CW_BAR), F.MISC + 8);
    const int bx = (int)blockIdx.x;

#ifndef NO_P0
    p0_prologue(F);
#endif
    xcd_barrier(bar);

    {
        pg8::Gemm g{DMODEL, DMODEL, DMODEL}; SchedIn S{F.G, bx, (const char*)((bf16*)(F.ws + WS_XB)), (const char*)((bf16*)(F.ws + WS_WIN))};
        EpiIn E{((float*)(F.ws + WS_RINV)), ((bf16*)(F.ws + WS_U)), ((bf16*)(F.ws + WS_GP)), ((bf16*)(F.ws + WS_Q)), ((bf16*)(F.ws + WS_KB)), ((bf16*)(F.ws + WS_VB)), ((bf16*)(F.ws + WS_GA)), ((bf16*)(F.ws + WS_MA)), ((bf16*)(F.ws + WS_MB)), F.out + O_KP, F.out + O_VP, F.out + O_PP, F.qg, F.kg};
#ifndef NO_G1
        pg8::gemm_phase<EpiIn, SchedIn, true, true>(F.lds + RING_OFF, g, S, E);
#endif
        __syncthreads();
#ifndef NO_S1
        for (int su = bx; su < NIN / 64; su += F.G) sample_in_unit(F, su);
#endif
    }
    xcd_barrier(bar);

#ifndef NO_DEC
    decode_partials(F);
#endif
#ifndef NO_PD
    pool_diff(F);
#endif
    xcd_barrier(bar);

    {
        const attn_body::AttnTensors AT{(const attn_body::bf16*)((bf16*)(F.ws + WS_Q)), (const attn_body::bf16*)((bf16*)(F.ws + WS_KB)), (const attn_body::bf16*)((bf16*)(F.ws + WS_VB)), (const attn_body::bf16*)((bf16*)(F.ws + WS_GA)), (attn_body::bf16*)(((bf16*)(F.ws + WS_AB)) + 1024), F.out + O_LFP};
        const attn_body::StaticOrder S((int)F.G, bx);
#ifndef NO_ATT
        attn_body::attn_phase<attn_body::StaticOrder>((char*)lds + RING_OFF, AT, S);
#endif
        __syncthreads();
        pg8::Gemm g{PW, 256, 256}; SchedPool SP{F.G, bx, (const char*)((bf16*)(F.ws + WS_D)), (const char*)((bf16*)(F.ws + WS_WPM))};
        EpiPool E{F.pool_scale, ((bf16*)(F.ws + WS_GP)), ((bf16*)(F.ws + WS_AB))};
#ifndef NO_GP
        pg8::gemm_phase<EpiPool, SchedPool, true, true>(F.lds + RING_OFF, g, SP, E);
#endif
        __syncthreads();
        if (bx >= 128 && bx < 144) sample_pool_unit(F, bx - 128);
#ifndef NO_CMB
        if (bx >= 144 && bx < 160) decode_combine(F, (bx - 144) * 8 + F.wave);
#endif
    }
    xcd_barrier(bar);

    {
        pg8::Gemm g{DMODEL, 1024, 1024}; SchedUp S{F.G, bx, (const char*)((bf16*)(F.ws + WS_AB)), (const char*)((bf16*)(F.ws + WS_WUP))};
        EpiUp E{((bf16*)(F.ws + WS_MA)), ((bf16*)(F.ws + WS_MB)), ((float*)(F.ws + WS_P32)), ((bf16*)(F.ws + WS_MG))};
#ifndef NO_G3
        pg8::gemm_phase<EpiUp, SchedUp, true, true>(F.lds + RING_OFF, g, S, E);
#endif
        __syncthreads();
        for (int j = bx; j < DMODEL / 64; j += F.G) sample_up_unit(F, j);
    }
    xcd_barrier(bar);

    {
        pg8::Gemm g{DMODEL, DMODEL, DMODEL}; SchedOut S{F.G, bx, (const char*)((bf16*)(F.ws + WS_MG)), (const char*)((bf16*)(F.ws + WS_WOUT))};
        EpiOut E{F.xp, F.out + O_YP};
#ifndef NO_G4
        pg8::gemm_phase<EpiOut, SchedOut, true, true>(F.lds + RING_OFF, g, S, E);
#endif
        __syncthreads();
        for (int j = bx; j < DMODEL / 64; j += F.G) sample_out_unit(F, j);
    }
#ifdef DIAG
    xcd_barrier(bar);
    diag_phase(F);
#endif
}

extern "C" void kernel_launch(void* const* d_in, const int* in_sizes, int n_in, void* d_out, int out_size, void* d_ws, size_t ws_size, hipStream_t stream) {
    static int grid = 0;
    if (grid == 0) {
        if (n_in != 17 || (size_t)out_size != O_END || ws_size < WS_END) { fprintf(stderr, "kernel_launch: unexpected shapes (n_in %d, out %d, ws %zu); nothing launched\n", n_in, out_size, ws_size); grid = -1; return; }
        int dev = 0, cus = 0, per_cu = 0;
        if (hipGetDevice(&dev) != hipSuccess || hipDeviceGetAttribute(&cus, hipDeviceAttributeMultiprocessorCount, dev) != hipSuccess) { grid = -1; return; }
        if (hipFuncSetAttribute((const void*)mega_fwd, hipFuncAttributeMaxDynamicSharedMemorySize, LDS_BYTES) != hipSuccess) { fprintf(stderr, "kernel_launch: hipFuncSetAttribute failed\n"); grid = -1; return; }
        if (hipOccupancyMaxActiveBlocksPerMultiprocessor(&per_cu, (const void*)mega_fwd, NWAVES * 64, LDS_BYTES) != hipSuccess || per_cu < 1) fprintf(stderr, "kernel_launch: occupancy query reports %d\n", per_cu);
        (void)hipGetLastError();
        grid = cus;
        if (grid != 256) fprintf(stderr, "kernel_launch: %d CUs; the work split assumes 256\n", grid);
    }
    if (grid < 0) return;
    if (hipMemsetAsync((char*)d_ws + WS_CTL, 0, CTL_ZERO_BYTES, stream) != hipSuccess) return;
    Args a{};
    for (int i = 0; i < 17; ++i) a.in[i] = (const float*)d_in[i];
    a.out = (float*)d_out; a.ws = (unsigned char*)d_ws;
    hipLaunchKernelGGL(mega_fwd, dim3(grid), dim3(NWAVES * 64), LDS_BYTES, stream, a);
}
```

```cpp
#include <hip/hip_runtime.h>
#include <hip/hip_bf16.h>
#include <cstdio>
#include <cstdint>
#include <cmath>

__device__ __forceinline__ int tid_fresh() { int t = threadIdx.x; asm volatile("" : "+v"(t)); return t; }
namespace pg8 {
#define PG8_LAS __attribute__((address_space(3)))
typedef unsigned short bf16_t;
typedef short bf16x8 __attribute__((ext_vector_type(8)));
typedef float f32x4 __attribute__((ext_vector_type(4)));
typedef unsigned u32x4 __attribute__((ext_vector_type(4)));
constexpr int BM = 256, BK = 64, HALF = 128, HTB = HALF * BK * 2  , STAGE_BYTES = 8 * HTB, NXCD = 8, WGM = 8;

__host__ __device__ __forceinline__ int lds_byte(int r, int c) { const int st = (r >> 4) * 2 + (c >> 5), rr = r & 15, cc = c & 31, ob = rr * 64 + cc * 2; return st * 1024 + (ob ^ (((ob >> 9) & 1) << 5)); }
__host__ __device__ __forceinline__ void stage_rc(int b, int& R, int& C) { const int st = b / 1024, sb = b % 1024, swz = sb ^ (((sb >> 9) & 1) << 5); R = (st >> 1) * 16 + swz / 64; C = (st & 1) * 32 + (swz % 64) / 2; }
__host__ __device__ __forceinline__ int perm32(int rho) { const int n = rho >> 4, i = rho & 15; return 8 * (i >> 2) + 4 * n + (i & 3); }

struct Unit { int pm, pn, aux; const char* a; const char* b; };
struct Gemm { int lda, ldb, K; };

__device__ __forceinline__ bool static_tile(int i, int G, int c, int nM, int nN, int& pm, int& pn) {
    const int nwg = nM * nN; const long L = (long)i * G + c; if (L >= nwg) return false;
    int wgid = (int)L; { const int q = nwg / NXCD, r = nwg % NXCD, xcd = wgid % NXCD, off = wgid / NXCD; wgid = (xcd < r ? xcd * (q + 1) : r * (q + 1) + (xcd - r) * q) + off; }
    const int nig = WGM * nN, gid = wgid / nig, fm = gid * WGM, gsz = (nM - fm) < WGM ? (nM - fm) : WGM;
    pm = fm + ((wgid % nig) % gsz); pn = (wgid % nig) / gsz; return true;
}
__device__ __forceinline__ unsigned cvt_pk_bf16(float lo, float hi) { unsigned r; asm volatile("s_nop 0\n\tv_cvt_pk_bf16_f32 %0, %1, %2" : "=v"(r) : "v"(lo), "v"(hi)); return r; }

#ifndef EPI_TWICE
#define EPI_TWICE 0
#endif
template <class Epi, class Sched, bool ALIGN_EPI = false, bool SP2 = false>
__device__ __forceinline__ void gemm_phase(PG8_LAS unsigned char* lds, const Gemm g, const Sched& S, const Epi& E) {
    const int tid = tid_fresh(), wid = __builtin_amdgcn_readfirstlane(tid >> 6), lane = tid & 63, wr = wid >> 2, wc = wid & 3, fr = lane & 15, fq = lane >> 4;
    const int K = g.K, nt = K / BK;
    unsigned voffA[2], voffB[2];
#pragma unroll
    for (int i = 0; i < 2; ++i) { int R, C; stage_rc(tid * 16 + i * 8192, R, C); const int Rb = Epi::PERM ? ((R & ~31) + perm32(R & 31)) : R;
        voffA[i] = (unsigned)(R * g.lda + C) * 2u; voffB[i] = (unsigned)(Rb * g.ldb + C) * 2u; }
    const size_t kstep = (size_t)(BK * 2);
    const size_t hA = (size_t)HALF * g.lda * 2, hB = (size_t)HALF * g.ldb * 2;
    const unsigned ldsw = (unsigned)wid * 1024u;
    const int aoff = lds_byte(wr * 64 + fr, fq * 8), boff = lds_byte(wc * 32 + fr, fq * 8);
#define PG8_SA(b, h) (((b) * 2 + (h)) * HTB)
#define PG8_SB(b, h) ((4 + (b) * 2 + (h)) * HTB)
#define PG8_STAGE(bufoff, gbase, voff) do { _Pragma("unroll") for (int _i = 0; _i < 2; ++_i) \
        __builtin_amdgcn_global_load_lds((const unsigned*)((const char*)(gbase) + (voff)[_i]), (PG8_LAS unsigned*)(lds + (bufoff) + ldsw + _i * 8192), 16, 0, 0); } while (0)
#define PG8_LDA(dst, b, h) do { _Pragma("unroll") for (int m = 0; m < 4; ++m) _Pragma("unroll") for (int k = 0; k < 2; ++k) dst[m][k] = *(const PG8_LAS bf16x8*)(lds + PG8_SA(b, h) + aoff + m * 2048 + k * 1024); } while (0)
#define PG8_LDB(dst, b, h) do { _Pragma("unroll") for (int n = 0; n < 2; ++n) _Pragma("unroll") for (int k = 0; k < 2; ++k) dst[n][k] = *(const PG8_LAS bf16x8*)(lds + PG8_SB(b, h) + boff + n * 2048 + k * 1024); } while (0)
#define PG8_MMA(ai, bj, At, Bt) do { __builtin_amdgcn_s_setprio(1); _Pragma("unroll") for (int m = 0; m < 4; ++m) _Pragma("unroll") for (int n = 0; n < 2; ++n) _Pragma("unroll") for (int k = 0; k < 2; ++k) \
        acc[ai][bj][m][n] = __builtin_amdgcn_mfma_f32_16x16x32_bf16(Bt[n][k], At[m][k], acc[ai][bj][m][n], 0, 0, 0); __builtin_amdgcn_s_setprio(0); } while (0)
#define PG8_WAIT_V(n) asm volatile("s_waitcnt vmcnt(" #n ")" ::: "memory")
#define PG8_WAIT_L(n) asm volatile("s_waitcnt lgkmcnt(" #n ")" ::: "memory")
#define PG8_BAR __builtin_amdgcn_s_barrier()
#define PG8_PF(it) do { if constexpr (Epi::HAS_PF) __builtin_amdgcn_global_load_lds((const unsigned*)E.pf((it), cur, wid, lane), (PG8_LAS unsigned*)(lds + 131072 + wid * 256), 4, 0, 0); } while (0)
#define PG8_WAIT_VP() do { if constexpr (Epi::HAS_PF) PG8_WAIT_V(9); else PG8_WAIT_V(8); } while (0)
#define PG8_SCHED __builtin_amdgcn_sched_barrier(0)
    Unit cur, nxt; int ui = 0;
    if (!S.next(0, cur)) return;
    f32x4 acc[2][2][4][2];
#pragma unroll
    for (int a = 0; a < 2; ++a)
#pragma unroll
        for (int b = 0; b < 2; ++b)
#pragma unroll
            for (int m = 0; m < 4; ++m)
#pragma unroll
                for (int n = 0; n < 2; ++n) acc[a][b][m][n] = (f32x4){0.f, 0.f, 0.f, 0.f};
    bf16x8 At[4][2], B0[2][2], B1[2][2];
    const char* cA = cur.a; const char* cB = cur.b;
    S.a_ready(cur);
    if constexpr (SP2) {
        PG8_STAGE(PG8_SB(0, 0), cB, voffB); PG8_STAGE(PG8_SB(0, 1), cB + hB, voffB); PG8_STAGE(PG8_SA(0, 0), cA, voffA); PG8_STAGE(PG8_SA(0, 1), cA + hA, voffA);
        if (wr == 1) PG8_BAR;
        PG8_WAIT_V(2); PG8_BAR;
        PG8_STAGE(PG8_SB(1, 0), cB + kstep, voffB); PG8_STAGE(PG8_SA(1, 0), cA + kstep, voffA); PG8_STAGE(PG8_SB(1, 1), cB + hB + kstep, voffB);
        PG8_WAIT_V(6); PG8_BAR;
    } else {
        PG8_STAGE(PG8_SB(0, 0), cB, voffB); PG8_STAGE(PG8_SA(0, 0), cA, voffA); PG8_STAGE(PG8_SB(0, 1), cB + hB, voffB); PG8_STAGE(PG8_SA(0, 1), cA + hA, voffA);
        if (wr == 1) PG8_BAR;
        PG8_WAIT_V(4); PG8_BAR;
        PG8_STAGE(PG8_SB(1, 0), cB + kstep, voffB); PG8_STAGE(PG8_SA(1, 0), cA + kstep, voffA); PG8_STAGE(PG8_SB(1, 1), cB + hB + kstep, voffB);
        PG8_WAIT_V(6); PG8_BAR;
    }
    for (;;) {
        const bool has_next = S.next(ui + 1, nxt);
        const char* nA = has_next ? nxt.a : cA; const char* nB = has_next ? nxt.b : cB;
        for (int t = 0; t < nt; t += 2) {
            if constexpr (Epi::HAS_MID) { if (t == nt / 2) E.mid(acc, cur, wr, wc); }
            const bool last = (t == nt - 2);
            const char* a1 = cA + (size_t)(t + 1) * kstep;
            const char* a2 = last ? nA : cA + (size_t)(t + 2) * kstep; const char* b2 = last ? nB : cB + (size_t)(t + 2) * kstep;
            const char* a3 = a2 + kstep; const char* b3 = b2 + kstep;
            if (last && has_next) S.a_ready(nxt);
            if constexpr (SP2) {
            PG8_LDB(B0, 0, 0); PG8_LDB(B1, 0, 1); PG8_SCHED; PG8_LDA(At, 0, 0); PG8_STAGE(PG8_SA(1, 1), a1 + hA, voffA); PG8_PF(t >> 1);
            PG8_WAIT_VP(); PG8_WAIT_L(0); PG8_BAR; PG8_MMA(0, 0, At, B0); PG8_MMA(0, 1, At, B1); PG8_BAR; PG8_SCHED;
            PG8_LDA(At, 0, 1); PG8_STAGE(PG8_SB(0, 0), b2, voffB); PG8_STAGE(PG8_SB(0, 1), b2 + hB, voffB); PG8_STAGE(PG8_SA(0, 0), a2, voffA);
            PG8_WAIT_VP(); PG8_WAIT_L(0); PG8_BAR; PG8_MMA(1, 0, At, B0); PG8_MMA(1, 1, At, B1); PG8_BAR; PG8_SCHED;
            PG8_LDB(B0, 1, 0); PG8_LDB(B1, 1, 1); PG8_SCHED; PG8_LDA(At, 1, 0); PG8_STAGE(PG8_SA(0, 1), a2 + hA, voffA);
            PG8_WAIT_VP(); PG8_WAIT_L(0); PG8_BAR; PG8_MMA(0, 0, At, B0); PG8_MMA(0, 1, At, B1); PG8_BAR; PG8_SCHED;
            PG8_LDA(At, 1, 1); PG8_STAGE(PG8_SB(1, 0), b3, voffB); PG8_STAGE(PG8_SB(1, 1), b3 + hB, voffB); PG8_STAGE(PG8_SA(1, 0), a3, voffA);
            PG8_WAIT_V(8); PG8_WAIT_L(0); PG8_BAR; PG8_MMA(1, 0, At, B0); PG8_MMA(1, 1, At, B1); PG8_BAR; PG8_SCHED;
            } else {
            static_assert(!Epi::HAS_PF, "the prefetch slot exists in the SP2 schedule only");
            PG8_LDB(B0, 0, 0); PG8_SCHED; PG8_LDA(At, 0, 0); PG8_STAGE(PG8_SA(1, 1), a1 + hA, voffA);
            PG8_WAIT_L(8); PG8_BAR; PG8_WAIT_L(0); PG8_MMA(0, 0, At, B0); PG8_BAR; PG8_SCHED;
            PG8_LDB(B1, 0, 1); PG8_STAGE(PG8_SB(0, 0), b2, voffB);
            PG8_BAR; PG8_WAIT_L(0); PG8_MMA(0, 1, At, B1); PG8_BAR;
            PG8_LDA(At, 0, 1); PG8_STAGE(PG8_SA(0, 0), a2, voffA);
            PG8_BAR; PG8_WAIT_L(0); PG8_MMA(1, 0, At, B0); PG8_BAR; PG8_SCHED;
            PG8_STAGE(PG8_SB(0, 1), b2 + hB, voffB);
            PG8_WAIT_V(6); PG8_BAR; PG8_MMA(1, 1, At, B1); PG8_BAR;
            PG8_LDB(B0, 1, 0); PG8_SCHED; PG8_LDA(At, 1, 0); PG8_STAGE(PG8_SA(0, 1), a2 + hA, voffA);
            PG8_WAIT_L(8); PG8_BAR; PG8_WAIT_L(0); PG8_MMA(0, 0, At, B0); PG8_BAR; PG8_SCHED;
            PG8_LDB(B1, 1, 1); PG8_STAGE(PG8_SB(1, 0), b3, voffB);
            PG8_BAR; PG8_WAIT_L(0); PG8_MMA(0, 1, At, B1); PG8_BAR;
            PG8_LDA(At, 1, 1); PG8_STAGE(PG8_SA(1, 0), a3, voffA);
            PG8_BAR; PG8_WAIT_L(0); PG8_MMA(1, 0, At, B0); PG8_BAR; PG8_SCHED;
            PG8_STAGE(PG8_SB(1, 1), b3 + hB, voffB);
            PG8_WAIT_V(6); PG8_BAR; PG8_MMA(1, 1, At, B1); PG8_BAR;
            }
        }
        if constexpr (ALIGN_EPI) { if (wr == 0) PG8_BAR; }
        if constexpr (!Epi::AFTER_DRAIN) { E(acc, cur, wr, wc, fr, fq);
            if constexpr ((EPI_TWICE & Epi::ID) != 0) E(acc, cur, wr, wc, fr, fq);
            S.done(cur); }
        else if (has_next) { E(acc, cur, wr, wc, fr, fq); S.done(cur); }
        if (!has_next) break;
#pragma unroll
        for (int a = 0; a < 2; ++a)
#pragma unroll
            for (int b = 0; b < 2; ++b)
#pragma unroll
                for (int m = 0; m < 4; ++m)
#pragma unroll
                    for (int n = 0; n < 2; ++n) acc[a][b][m][n] = (f32x4){0.f, 0.f, 0.f, 0.f};
        cur = nxt; cA = nA; cB = nB; ++ui;
        if constexpr (ALIGN_EPI) { if (wr == 1) PG8_BAR; }
    }
    PG8_WAIT_V(0);
    if constexpr (!ALIGN_EPI) { if (wr == 0) PG8_BAR; }
    PG8_BAR;
    if constexpr (Epi::AFTER_DRAIN) { E.fused(acc, cur, wr, wc, fr, fq, lds, wid, lane);
        if constexpr ((EPI_TWICE & Epi::ID) != 0) E.fused(acc, cur, wr, wc, fr, fq, lds, wid, lane);
        S.done(cur); }
#undef PG8_SA
#undef PG8_SB
#undef PG8_STAGE
#undef PG8_LDA
#undef PG8_LDB
#undef PG8_MMA
#undef PG8_WAIT_V
#undef PG8_WAIT_L
#undef PG8_BAR
#undef PG8_PF
#undef PG8_WAIT_VP
#undef PG8_SCHED
}
}

#include <hip/hip_bf16.h>
#include <cmath>
namespace attn_body {
using bf16=__hip_bfloat16;
using bf16x8=__attribute__((ext_vector_type(8)))short;
using s16x4=__attribute__((ext_vector_type(4)))short;
using f32x16=__attribute__((ext_vector_type(16)))float;
using u32x4=__attribute__((ext_vector_type(4)))unsigned;
constexpr int BATCH=4,NHEAD=16,SEQ=2048,D=64,DM=NHEAD*D,OPITCH=2048;
constexpr int NW=8,QBLK=32,QB=QBLK*NW,KVBLK=64,NQB=SEQ/QB;
constexpr int ATTN_PITCH=DM, ATTN_UNIT_ROWS=QB;
__device__ __forceinline__ int crow(int r,int hi){return (r&3)+8*(r>>2)+4*hi;}
#define SBAR() __builtin_amdgcn_sched_barrier(0)
__device__ __forceinline__ void cmask(f32x16&p0,f32x16&p1,int jb,int qrel,int hi){
  const float NEG=-INFINITY; int kb=64*jb+4*hi;
  #pragma unroll
  for(int r=0;r<16;++r){int kv=kb+(r&3)+8*(r>>2); if(kv>qrel)p0[r]=NEG; if(kv+32>qrel)p1[r]=NEG;}
}

constexpr int NSLOT=3, SLOTB=8192;
constexpr int LDS_K=0, LDS_V=NSLOT*SLOTB, LDS_WS=2*NSLOT*SLOTB, LDS_OST=LDS_WS+NW*64*4, LDS_FS2=LDS_OST+NW*4096, LDS_BYTES=LDS_FS2+SEQ*4;
constexpr float C2=0.125f*1.4426950408889634f;
__device__ __forceinline__ void glds16(const void*gsrc,unsigned lds_dst){unsigned keep;
  asm volatile("s_mov_b32 %0, m0\n\ts_mov_b32 m0, %2\n\ts_nop 0\n\tglobal_load_lds_dwordx4 %1, off\n\ts_mov_b32 m0, %0":"=&s"(keep):"v"(gsrc),"s"(lds_dst):"memory");}
__device__ __forceinline__ float max3f(float a,float b,float c){float r;asm("v_max3_f32 %0, %1, %2, %3":"=v"(r):"v"(a),"v"(b),"v"(c));return r;}
__device__ __forceinline__ float max2f(float a,float b){float r;asm("v_max_f32_e32 %0, %1, %2":"=v"(r):"v"(a),"v"(b));return r;}
__device__ __forceinline__ float fadd_s(float a,float b){float r;asm("v_add_f32_e32 %0, %1, %2":"=v"(r):"v"(a),"v"(b));return r;}
__device__ __forceinline__ float fsub_s(float a,float b){float r;asm("v_sub_f32_e32 %0, %1, %2":"=v"(r):"v"(a),"v"(b));return r;}
typedef float f32x2_t __attribute__((ext_vector_type(2))); typedef __bf16 bf16x2_t __attribute__((ext_vector_type(2)));
__device__ __forceinline__ unsigned cvtpk_s(float lo,float hi){f32x2_t v={lo,hi};bf16x2_t b=__builtin_convertvector(v,bf16x2_t);return __builtin_bit_cast(unsigned,b);}
#define WAIT_BAR(N) asm volatile("s_waitcnt vmcnt(" #N ") lgkmcnt(0)\n\ts_barrier":::"memory")

__device__ __forceinline__ void qkt(f32x16&p0,f32x16&p1,const char*Kslot,const bf16x8*qr,int r32,int hi){
  const char*kb=Kslot+hi*1024+r32*16;
  #pragma unroll
  for(int d0=0;d0<4;++d0){
    const bf16x8 b0=*reinterpret_cast<const bf16x8*>(kb+d0*2048);
    const bf16x8 b1=*reinterpret_cast<const bf16x8*>(kb+d0*2048+512);
    {p0=__builtin_amdgcn_mfma_f32_32x32x16_bf16(b0,qr[d0],p0,0,0,0);p1=__builtin_amdgcn_mfma_f32_32x32x16_bf16(b1,qr[d0],p1,0,0,0);}}
}
typedef __attribute__((address_space(3))) const char* lds_cptr;
typedef short v4i16_t __attribute__((ext_vector_type(4)));
__device__ __forceinline__ void kload8(bf16x8*kf,lds_cptr kp){
  kf[0]=*(const __attribute__((address_space(3))) bf16x8*)(kp);      kf[1]=*(const __attribute__((address_space(3))) bf16x8*)(kp+512);
  kf[2]=*(const __attribute__((address_space(3))) bf16x8*)(kp+2048); kf[3]=*(const __attribute__((address_space(3))) bf16x8*)(kp+2560);
  kf[4]=*(const __attribute__((address_space(3))) bf16x8*)(kp+4096); kf[5]=*(const __attribute__((address_space(3))) bf16x8*)(kp+4608);
  kf[6]=*(const __attribute__((address_space(3))) bf16x8*)(kp+6144); kf[7]=*(const __attribute__((address_space(3))) bf16x8*)(kp+6656);
}
__device__ __forceinline__ void kload2(bf16x8*kf,lds_cptr kp,int j){ kf[2*j]=*(const __attribute__((address_space(3))) bf16x8*)(kp+j*2048); kf[2*j+1]=*(const __attribute__((address_space(3))) bf16x8*)(kp+j*2048+512); }
__device__ __forceinline__ s16x4 vtr(lds_cptr p){ return __builtin_bit_cast(s16x4,__builtin_amdgcn_ds_read_tr16_b64_v4i16((__attribute__((address_space(3))) v4i16_t*)p)); }
__device__ __forceinline__ float rowmax(const f32x16&p0,const f32x16&p1){
  float a=max3f(p0[0],p0[1],p1[0]),b=max3f(p0[2],p0[3],p1[1]);a=max3f(a,p1[2],p1[3]);
  #pragma unroll
  for(int r=4;r<16;r+=4){a=max3f(a,p0[r],p0[r+1]);b=max3f(b,p0[r+2],p0[r+3]);a=max3f(a,p1[r],p1[r+1]);b=max3f(b,p1[r+2],p1[r+3]);}
  const float m=max2f(a,b);
  auto rr=__builtin_amdgcn_permlane32_swap(__float_as_uint(m),__float_as_uint(m),false,false);
  return max2f(__uint_as_float(rr[0]),__uint_as_float(rr[1]));
}
__device__ __forceinline__ void pv(f32x16*o,int vb,bf16x8 pa0,bf16x8 pa1,bf16x8 pa2,bf16x8 pa3){
  #pragma unroll
  for(int d0=0;d0<2;++d0){s16x4 lo[4],hi[4];
    #pragma unroll
    for(int ks=0;ks<4;++ks){
      asm volatile("ds_read_b64_tr_b16 %0,%1 offset:%c2":"=&v"(lo[ks]):"v"(vb),"i"(d0*4096+ks*1024):"memory");
      asm volatile("ds_read_b64_tr_b16 %0,%1 offset:%c2":"=&v"(hi[ks]):"v"(vb),"i"(d0*4096+ks*1024+512):"memory");}
    asm volatile("s_waitcnt lgkmcnt(0)":::"memory");SBAR();
    #define PK(k) (bf16x8){lo[k][0],lo[k][1],lo[k][2],lo[k][3],hi[k][0],hi[k][1],hi[k][2],hi[k][3]}
    o[d0]=__builtin_amdgcn_mfma_f32_32x32x16_bf16(pa0,PK(0),o[d0],0,0,0);
    o[d0]=__builtin_amdgcn_mfma_f32_32x32x16_bf16(pa1,PK(1),o[d0],0,0,0);
    o[d0]=__builtin_amdgcn_mfma_f32_32x32x16_bf16(pa2,PK(2),o[d0],0,0,0);
    o[d0]=__builtin_amdgcn_mfma_f32_32x32x16_bf16(pa3,PK(3),o[d0],0,0,0);
    #undef PK
  }
}

#ifndef ATTN_STORE16
#define ATTN_STORE16(p,v) (*(u32x4*)(p)=(v))
#endif
template<int THRL> __device__ __forceinline__ void attn_unit(int b,int h,int qb,const bf16*Q,const bf16*__restrict__ K,const bf16*__restrict__ V,const bf16*__restrict__ G,bf16*O,char*shm){
  const int tid=tid_fresh(),lane=tid&63,r32=lane&31,hi=lane>>5; const int wid=__builtin_amdgcn_readfirstlane(tid>>6);
  const long rowbase=(long)b*SEQ; const int q0=qb*QB;
  const bf16*Qw=Q+(rowbase+q0+wid*QBLK)*DM+h*D;
  const bf16*Kh=K+rowbase*DM+h*D,*Vh=V+rowbase*DM+h*D;
  const unsigned lds0=(unsigned)(uintptr_t)shm;
  float*wsf=(float*)(shm+LDS_WS)+wid*64;
  const bf16*ksrc=Kh+(long)lane*DM+wid*8;
  const bf16*vsrc=Vh+(long)(16*(wid&3)+(lane>>2))*DM+(wid>>2)*32+(lane&3)*8;
  const unsigned kdst=lds0+LDS_K+wid*1024, vdst=lds0+LDS_V+wid*1024;
  #define DMA_K(t,slot) glds16(ksrc+(long)(t)*KVBLK*DM,(unsigned)__builtin_amdgcn_readfirstlane(kdst+(slot)))
  #define DMA_V(t,slot) glds16(vsrc+(long)(t)*KVBLK*DM,(unsigned)__builtin_amdgcn_readfirstlane(vdst+(slot)))
  const int vb0=(int)(lds0+LDS_V)+((lane>>4)&1)*32+(lane&3)*8+(4*hi+((lane&15)>>2))*64;
  const char*Kbase=shm+LDS_K; bf16x8 kf[8];
  const lds_cptr shm3=(lds_cptr)shm; const lds_cptr kp0=shm3+LDS_K+hi*1024+r32*16; const lds_cptr vp0=shm3+LDS_V+((lane>>4)&1)*32+(lane&3)*8+(4*hi+((lane&15)>>2))*64;
  typedef float f32x4a __attribute__((ext_vector_type(4)));
  const __attribute__((address_space(3))) f32x4a* fsb=(const __attribute__((address_space(3))) f32x4a*)(shm3+LDS_FS2)+hi;
  #define BINIT(P,t,o32) do{ const __attribute__((address_space(3))) f32x4a* fb_=fsb+(t)*16+(o32)*8; \
    _Pragma("unroll") for(int rg_=0;rg_<4;++rg_){ const f32x4a b0_=fb_[2*rg_]; \
      P[4*rg_]=b0_[0]-mhat;P[4*rg_+1]=b0_[1]-mhat;P[4*rg_+2]=b0_[2]-mhat;P[4*rg_+3]=b0_[3]-mhat; } asm volatile("":"+v"(P)); SBAR(); }while(0)
  const int NT=(q0+QB)/KVBLK;
  DMA_K(0,0);DMA_V(0,0);DMA_K(1,SLOTB);
  bf16x8 qr[4];
  #pragma unroll
  for(int d0=0;d0<4;++d0)qr[d0]=*reinterpret_cast<const bf16x8*>(&Qw[(long)r32*DM+d0*16+hi*8]);
  float mhat=0.f,l_reg=0.f;f32x16 o[2];o[0]=f32x16{};o[1]=f32x16{};
  const int qrel=wid*QBLK+r32;
  #define CMASK(P0,P1,t) do{int jb_=(t)-(NT-4); if(jb_>=0)cmask(P0,P1,jb_,qrel,hi);}while(0)
  bool resc=false;
  #define START(P0,P1) do{ const float rm=rowmax(P0,P1); resc=false; \
    { const float dl=rm; mhat=fadd_s(mhat,dl); \
      _Pragma("unroll") for(int r=0;r<16;++r){P0[r]=fsub_s(P0[r],dl);P1[r]=fsub_s(P1[r],dl);} \
      } \
    _Pragma("unroll") for(int r=0;r<16;++r)P0[r]=__builtin_amdgcn_exp2f(P0[r]); }while(0)
  #define RESC() do{ if(resc){ asm volatile("s_waitcnt lgkmcnt(0)":::"memory"); \
      _Pragma("unroll") for(int d_=0;d_<2;++d_) _Pragma("unroll") for(int r=0;r<16;++r)o[d_][r]*=wsf[crow(r,hi)]; } }while(0)
  f32x16 pA0,pA1,pB0,pB1;
  int sl_prev=0,sl_cur=0,sl_next=SLOTB;
  #define ROT() do{sl_prev=sl_cur;sl_cur=sl_next;sl_next=(sl_next==(NSLOT-1)*SLOTB)?0:sl_next+SLOTB;}while(0)
  DMA_K(2,2*SLOTB);
  WAIT_BAR(3);
  BINIT(pA0,0,0);BINIT(pA1,0,1);qkt(pA0,pA1,Kbase,qr,r32,hi);asm volatile("s_nop 15\n\ts_nop 7":"+v"(pA0),"+v"(pA1));CMASK(pA0,pA1,0);
  START(pA0,pA1);
  _Pragma("unroll") for(int r=0;r<16;++r)pA1[r]=__builtin_amdgcn_exp2f(pA1[r]);
  WAIT_BAR(0);
  DMA_K(3,0);DMA_V(1,SLOTB);
  ROT();
  kload8(kf,kp0+sl_cur);
  WAIT_BAR(2);
  s16x4 vlo[8],vhi[8]; u32x4 pw0,pw1,pw2,pw3;
  #define PKW(P,B) cvtpk_s(P[B],P[B+1])
  #define PAF(k) __builtin_bit_cast(bf16x8,pw##k)
  #define VFR(i) (bf16x8){vlo[i][0],vlo[i][1],vlo[i][2],vlo[i][3],vhi[i][0],vhi[i][1],vhi[i][2],vhi[i][3]}
  #define PIN(x) asm volatile("":"+v"(x))
  #define MX3(a,b,c) __builtin_fmaxf(__builtin_fmaxf((a),(b)),(c))
  #define GAPA(MF,A0,A1,A2,A3,W0,W1,PW) do{ MF; sacc+=A0; sacc+=A1; sacc+=A2; sacc+=A3; PIN(sacc); W0; W1; PIN(PW); SBAR(); }while(0)
  #define EX(v) __builtin_amdgcn_exp2f(v)
  #define GAPB(MF,X,B) do{ MF; X[B]=EX(X[B]); X[B+1]=EX(X[B+1]); X[B+2]=EX(X[B+2]); X[B+3]=EX(X[B+3]); PIN(X); SBAR(); }while(0)
  #define VRD(i) do{ vlo[i]=vtr(vp_+(((i)>>2)*4096+((i)&3)*1024)); vhi[i]=vtr(vp_+(((i)>>2)*4096+((i)&3)*1024+512)); }while(0)
  #define KRD(G,j) do{ if(G){ kload2(kf,kp0+sl_next,j); SBAR(); } }while(0)
  #define STEP(C0,C1,P0,P1,t,GK,GV,GL) do{ SBAR(); \
    const lds_cptr vp_=vp0+sl_prev; \
    BINIT(C0,t,0); VRD(0); SBAR(); float sacc=(P0[0]+P0[1]); \
    GAPA(C0=__builtin_amdgcn_mfma_f32_32x32x16_bf16(kf[0],qr[0],C0,0,0,0), P0[2],P0[3],P0[4],P0[5],     pw0[0]=PKW(P0,0), pw0[1]=PKW(P0,2), pw0); \
    BINIT(C1,t,1); VRD(4); SBAR(); GAPA(C1=__builtin_amdgcn_mfma_f32_32x32x16_bf16(kf[1],qr[0],C1,0,0,0), P0[6],P0[7],P0[8],P0[9],     pw0[2]=PKW(P0,4), pw0[3]=PKW(P0,6), pw0); \
    VRD(1); SBAR(); GAPA(C0=__builtin_amdgcn_mfma_f32_32x32x16_bf16(kf[2],qr[1],C0,0,0,0),   P0[10],P0[11],P0[12],P0[13], pw1[0]=PKW(P0,8), pw1[1]=PKW(P0,10), pw1); \
    VRD(5); SBAR(); GAPA(C1=__builtin_amdgcn_mfma_f32_32x32x16_bf16(kf[3],qr[1],C1,0,0,0),   P0[14],P0[15],P1[0],P1[1],   pw1[2]=PKW(P0,12),pw1[3]=PKW(P0,14), pw1); \
    VRD(2); SBAR(); GAPA(C0=__builtin_amdgcn_mfma_f32_32x32x16_bf16(kf[4],qr[2],C0,0,0,0),   P1[2],P1[3],P1[4],P1[5],     pw2[0]=PKW(P1,0), pw2[1]=PKW(P1,2), pw2); \
    VRD(6); SBAR(); GAPA(C1=__builtin_amdgcn_mfma_f32_32x32x16_bf16(kf[5],qr[2],C1,0,0,0),   P1[6],P1[7],P1[8],P1[9],     pw2[2]=PKW(P1,4), pw2[3]=PKW(P1,6), pw2); \
    VRD(3); SBAR(); GAPA(C0=__builtin_amdgcn_mfma_f32_32x32x16_bf16(kf[6],qr[3],C0,0,0,0),   P1[10],P1[11],P1[12],P1[13], pw3[0]=PKW(P1,8), pw3[1]=PKW(P1,10), pw3); \
    VRD(7); SBAR(); GAPA(C1=__builtin_amdgcn_mfma_f32_32x32x16_bf16(kf[7],qr[3],C1,0,0,0),   P1[14],P1[15],0.f,0.f,       pw3[2]=PKW(P1,12),pw3[3]=PKW(P1,14), pw3); \
    l_reg+=sacc; \
    if(GK){DMA_K((t)+3,sl_cur);} if(GV){DMA_V((t)+1,sl_next);} \
    CMASK(C0,C1,t); \
    { float a=MX3(C0[0],C0[1],C1[0]),b=MX3(C0[2],C0[3],C1[1]); a=MX3(a,C1[2],C1[3]); \
      _Pragma("unroll") for(int r=4;r<16;r+=4){a=MX3(a,C0[r],C0[r+1]);b=MX3(b,C0[r+2],C0[r+3]);a=MX3(a,C1[r],C1[r+1]);b=MX3(b,C1[r+2],C1[r+3]);} \
      float rm=__builtin_fmaxf(a,b); { auto rr=__builtin_amdgcn_permlane32_swap(__float_as_uint(rm),__float_as_uint(rm),false,false); rm=__builtin_fmaxf(__uint_as_float(rr[0]),__uint_as_float(rr[1])); } \
      resc=false; \
      if(__builtin_expect(__any(rm>(float)THRL),0)){ const float dl=__builtin_fmaxf(rm,0.f); mhat+=dl; \
        _Pragma("unroll") for(int r=0;r<16;++r){C0[r]-=dl;C1[r]-=dl;} \
        const float f=__builtin_amdgcn_exp2f(-dl); l_reg*=f; if(hi==0)wsf[r32]=f; resc=true; } } \
    SBAR(); \
    GAPB(o[0]=__builtin_amdgcn_mfma_f32_32x32x16_bf16(PAF(0),VFR(0),o[0],0,0,0), C0,0); \
    GAPB(o[1]=__builtin_amdgcn_mfma_f32_32x32x16_bf16(PAF(0),VFR(4),o[1],0,0,0), C0,4); \
    KRD(GL,0); GAPB(o[0]=__builtin_amdgcn_mfma_f32_32x32x16_bf16(PAF(1),VFR(1),o[0],0,0,0), C0,8); \
    KRD(GL,1); GAPB(o[1]=__builtin_amdgcn_mfma_f32_32x32x16_bf16(PAF(1),VFR(5),o[1],0,0,0), C0,12); \
    KRD(GL,2); GAPB(o[0]=__builtin_amdgcn_mfma_f32_32x32x16_bf16(PAF(2),VFR(2),o[0],0,0,0), C1,0); \
    KRD(GL,3); GAPB(o[1]=__builtin_amdgcn_mfma_f32_32x32x16_bf16(PAF(2),VFR(6),o[1],0,0,0), C1,4); \
    GAPB(o[0]=__builtin_amdgcn_mfma_f32_32x32x16_bf16(PAF(3),VFR(3),o[0],0,0,0), C1,8); \
    GAPB(o[1]=__builtin_amdgcn_mfma_f32_32x32x16_bf16(PAF(3),VFR(7),o[1],0,0,0), C1,12); \
    }while(0)
  int t=1;
  #undef CMASK
  #define CMASK(P0,P1,t) do{}while(0)
  for(;t+5<NT;t+=2){
    STEP(pB0,pB1,pA0,pA1,t,true,true,true);     WAIT_BAR(2); RESC(); ROT();
    STEP(pA0,pA1,pB0,pB1,t+1,true,true,true);   WAIT_BAR(2); RESC(); ROT();
  }
  #undef CMASK
  #define CMASK(P0,P1,t) do{int jb_=(t)-(NT-4); if(jb_>=0)cmask(P0,P1,jb_,qrel,hi);}while(0)
  #define ENDW(tt) do{ if((tt)+3<NT){WAIT_BAR(2);} else if((tt)+2<NT){WAIT_BAR(1);} else {WAIT_BAR(0);} }while(0)
  for(;t+1<NT;t+=2){
    STEP(pB0,pB1,pA0,pA1,t,(t+3<NT),(t+1<NT),(t+1<NT));       ENDW(t);   RESC(); ROT();
    STEP(pA0,pA1,pB0,pB1,t+1,(t+4<NT),(t+2<NT),(t+2<NT));     ENDW(t+1); RESC(); ROT();
  }
  STEP(pB0,pB1,pA0,pA1,NT-1,false,false,false); RESC();
  { float sacc=pB0[0]+pB0[1]; _Pragma("unroll") for(int r=2;r<16;++r)sacc+=pB0[r]; _Pragma("unroll") for(int r=0;r<16;++r)sacc+=pB1[r]; l_reg+=sacc;
    pw0=(u32x4){PKW(pB0,0),PKW(pB0,2),PKW(pB0,4),PKW(pB0,6)};pw1=(u32x4){PKW(pB0,8),PKW(pB0,10),PKW(pB0,12),PKW(pB0,14)};pw2=(u32x4){PKW(pB1,0),PKW(pB1,2),PKW(pB1,4),PKW(pB1,6)};pw3=(u32x4){PKW(pB1,8),PKW(pB1,10),PKW(pB1,12),PKW(pB1,14)};
    SBAR(); pv(o,vb0+sl_cur,PAF(0),PAF(1),PAF(2),PAF(3)); }
  #undef PKW
  #undef PAF
  #undef VFR
  #undef PIN
  #undef MX3
  #undef GAPA
  #undef GAPB
  #undef EX
  #undef VRD
  #undef KRD
  #undef STEP
  #undef ENDW
  {auto rr=__builtin_amdgcn_permlane32_swap(__float_as_uint(l_reg),__float_as_uint(l_reg),false,false);l_reg=__uint_as_float(rr[0])+__uint_as_float(rr[1]);}
  if(hi==0)wsf[32+r32]=l_reg;asm volatile("s_waitcnt lgkmcnt(0)":::"memory");
  float rli[16];
  #pragma unroll
  for(int r=0;r<16;++r)rli[r]=__builtin_amdgcn_rcpf(wsf[32+crow(r,hi)]);
  bf16*Ow=O+(rowbase+q0+wid*QBLK)*OPITCH+h*D; const bf16*Gw=G+(rowbase+q0+wid*QBLK)*DM+h*D;
  { bf16*stg=(bf16*)(shm+LDS_OST)+wid*2048;
    #pragma unroll
    for(int r=0;r<16;++r){const int orow=crow(r,hi);
      #pragma unroll
      for(int d0=0;d0<2;++d0)stg[orow*64+d0*32+r32]=__float2bfloat16(o[d0][r]*rli[r]);}
    asm volatile("s_waitcnt lgkmcnt(0)":::"memory");
    #pragma unroll
    for(int i=0;i<4;++i){const int row=i*8+(lane>>3),ch=lane&7; const u32x4 v=*(const u32x4*)(stg+row*64+ch*8); const u32x4 gv=*(const u32x4*)(Gw+(long)row*DM+ch*8); u32x4 w;
      #pragma unroll
      for(int e=0;e<4;++e){ const float a0=__uint_as_float(v[e]<<16)*__uint_as_float(gv[e]<<16), a1=__uint_as_float(v[e]&0xffff0000u)*__uint_as_float(gv[e]&0xffff0000u); w[e]=cvtpk_s(a0,a1); }
      ATTN_STORE16(Ow+(long)row*OPITCH+ch*8,w);} }
  asm volatile("s_waitcnt lgkmcnt(0)\n\ts_barrier":::"memory");
  #undef DMA_K
  #undef DMA_V
  #undef CMASK
  #undef START
  #undef RESC
  #undef ROT
  #undef BINIT
}
typedef float f32x4w __attribute__((ext_vector_type(4)));
__device__ __forceinline__ void bias_table(char*shm,const float*logf,int b,int h){
  const int tid=tid_fresh(),lane=tid&63,wid=tid>>6; float*ws=(float*)(shm+LDS_WS); float*fs=(float*)(shm+LDS_FS2);
  const float*src=logf+((long)b*SEQ+4*tid)*16+h;
  const float v0=src[0],v1=src[16],v2=src[32],v3=src[48]; const float p0=v0,p1=p0+v1,p2=p1+v2,p3=p2+v3;
  float inc=p3;
  #pragma unroll
  for(int o=1;o<64;o<<=1){ const float y=__shfl_up(inc,o); if(lane>=o)inc+=y; }
  if(lane==63)ws[wid]=inc;
  __syncthreads();
  float woff=0.f;
  #pragma unroll
  for(int w=0;w<8;++w){ const float x=ws[w]; if(w<wid)woff+=x; }
  const float ex=woff+inc-p3; const float L2E=-1.4426950408889634f;
  f32x4w o; o[0]=(ex+p0)*L2E;o[1]=(ex+p1)*L2E;o[2]=(ex+p2)*L2E;o[3]=(ex+p3)*L2E;
  *(f32x4w*)(fs+4*tid)=o;
  __syncthreads();
}
constexpr int ATTN_LDS_BYTES=LDS_BYTES;
struct AttnTensors { const bf16* Q; const bf16* K; const bf16* V; const bf16* G; bf16* O; const float* logf; };
struct AttnUnit { int bh; int qb; };
struct StaticOrder {
  int vcu;
  __device__ __forceinline__ explicit StaticOrder(int grid,int block):vcu((block%8)*(grid/8)+block/8){}
  __device__ __forceinline__ bool next(int i,AttnUnit&u)const{ if(i>=2||vcu>=BATCH*NHEAD*4)return false; const int s=vcu&3; u.bh=vcu>>2; u.qb=(i==0)?7-s:s; return true; }
  __device__ __forceinline__ void a_ready(const AttnUnit&)const{}
  __device__ __forceinline__ void done(const AttnUnit&)const{}
};
template<class Sched,int THRL=8> __device__ __forceinline__ void attn_phase(char*lds,const AttnTensors&T,const Sched&S){
  AttnUnit u;
  if(!S.next(0,u))return;
  bias_table(lds,T.logf,u.bh/NHEAD,u.bh%NHEAD);
  for(int i=0;S.next(i,u);++i){ S.a_ready(u); attn_unit<THRL>(u.bh/NHEAD,u.bh%NHEAD,u.qb,T.Q,T.K,T.V,T.G,T.O,lds); S.done(u); }
}
#undef SBAR
#undef WAIT_BAR
}

constexpr int NWAVES = 8;
constexpr int DMODEL = 2048, NB = 4, SEQ = 2048, MP = NB * SEQ, DB = 8, DS = 8, MS = DB * DS, MT = MP + MS;
constexpr int NH = 16, HD = 64, AW = 1024, PW = 1024, INC = 10256, NIN = 10240, FLC = 6144;
constexpr int PAGE = 128, NPG = 128, PBUF = 15;
constexpr float EPS = 1e-6f, LOG2E = 1.4426950408889634f, C2 = 0.125f * 1.4426950408889634f;
constexpr size_t O_YP = 0, O_YS = O_YP + (size_t)MP * DMODEL, O_KP = O_YS + (size_t)MS * DMODEL, O_VP = O_KP + (size_t)MP * AW, O_LFP = O_VP + (size_t)MP * AW,
                 O_PP = O_LFP + (size_t)MP * NH, O_KS = O_PP + (size_t)NB * PBUF * PW, O_VS = O_KS + (size_t)MS * AW, O_LFS = O_VS + (size_t)MS * AW, O_PS = O_LFS + (size_t)MS * NH,
                 O_END = O_PS + (size_t)DB * PBUF * PW;
constexpr size_t MiB = 1u << 20;
constexpr size_t WS_CTL = 0, CTL_ZERO_BYTES = 1 * MiB;
constexpr size_t WS_WIN = 2 * MiB, WS_WPM = 42 * MiB, WS_WUP = 43 * MiB, WS_WOUT = 51 * MiB;
constexpr size_t WS_XB = 60 * MiB, WS_RINV = 93 * MiB, WS_PSUM = 94 * MiB;
constexpr size_t WS_U = 95 * MiB, WS_GP = 112 * MiB, WS_Q = 129 * MiB, WS_KB = 146 * MiB, WS_VB = 163 * MiB, WS_GA = 180 * MiB, WS_D = 197 * MiB;
constexpr size_t WS_MA = 214 * MiB, WS_MB = 247 * MiB, WS_AB = 280 * MiB, WS_MG = 313 * MiB;
constexpr size_t WS_MA8 = 346 * MiB, WS_MB8 = 364 * MiB;
constexpr size_t WS_P32 = 382 * MiB, WS_PO = 410 * MiB, WS_PML = 418 * MiB, WS_END = 420 * MiB;
constexpr int CW_TMO = 0, CW_CODE = 1, CW_BAR = 4096, CW_QFLAG = 8192;
constexpr int RING_OFF = 0, RING_BYTES = 131072;
constexpr int LDSCTL_OFF = 143360, MISC_OFF = LDSCTL_OFF + 320;
constexpr int LDS_BYTES = 147456;
static_assert(MISC_OFF + 128 <= LDS_BYTES, "LDS map");

#define GAS __attribute__((address_space(1)))
#define LAS __attribute__((address_space(3)))
typedef unsigned short bf16;
typedef unsigned v4u __attribute__((ext_vector_type(4)));
typedef float f32x4 __attribute__((ext_vector_type(4)));
typedef short bf16x8 __attribute__((ext_vector_type(8)));
typedef GAS unsigned gu32;
typedef GAS unsigned long long gu64;
#define RLX_AGENT __ATOMIC_RELAXED, __HIP_MEMORY_SCOPE_AGENT
#define LDS_WAIT() asm volatile("s_waitcnt lgkmcnt(0)" ::: "memory")
#define VM_WAIT() asm volatile("s_waitcnt vmcnt(0)" ::: "memory")
__device__ __forceinline__ unsigned long long rt() { return __builtin_amdgcn_s_memrealtime(); }
__device__ __forceinline__ unsigned f2bf(float f) { unsigned u = __builtin_bit_cast(unsigned, f); return (u + 0x7fffu + ((u >> 16) & 1u)) >> 16; }
__device__ __forceinline__ unsigned pk2(float lo, float hi) { return f2bf(lo) | (f2bf(hi) << 16); }

#define XB_TMO      128
#define XB_XCNT(j)  (256  + 64 * (j))
#define XB_XSUB(j)  (1280 + 64 * (j))
#define XB_XGEN(j)  (2304 + 64 * (j))
#define XB_TOP      3328
#define XB_TOPGEN   3392
#define XCD_BAR_WORDS 3456
#define XB_SPIN_CAP (1u << 18)

__device__ __forceinline__ unsigned xb_ld(unsigned* p)              { return __hip_atomic_load(p, __ATOMIC_RELAXED, __HIP_MEMORY_SCOPE_AGENT); }
__device__ __forceinline__ unsigned xb_add(unsigned* p, unsigned v) { return __hip_atomic_fetch_add(p, v, __ATOMIC_RELAXED, __HIP_MEMORY_SCOPE_AGENT); }
__device__ __forceinline__ unsigned xb_xcc_id() { return (unsigned)__builtin_amdgcn_s_getreg((3 << 11) | 20) & 0xFu; }
#define XB_SPIN(cond, bar) do { unsigned _sp = 0; while (cond) { __builtin_amdgcn_s_sleep(1); \
    if ((++_sp & 255u) == 0u) { if (xb_ld(&(bar)[XB_TMO])) break; if (_sp > XB_SPIN_CAP) { atomicAdd(&(bar)[XB_TMO], 1u); break; } } } } while (0)

struct XcdBarrier {
    unsigned* bar; unsigned x;
    volatile LAS unsigned* st;
};

__device__ __forceinline__ XcdBarrier xcd_barrier_post(unsigned* bar, volatile LAS unsigned* st) {
    XcdBarrier b; b.bar = bar; b.x = xb_xcc_id(); b.st = st;
    if (threadIdx.x == 0) (void)xb_add(&bar[XB_XCNT(b.x)], 1u);
    return b;
}
__device__ __forceinline__ void xcd_barrier_complete(unsigned* bar, unsigned x, unsigned& nloc, unsigned& nx) {
    const unsigned G = gridDim.x * gridDim.y * gridDim.z;
    unsigned sum, cnt, mine, sp = 0u;
    for (;;) {
        sum = 0u; cnt = 0u; mine = 0u;
#pragma unroll
        for (unsigned j = 0; j < 16; ++j) { const unsigned c = xb_ld(&bar[XB_XCNT(j)]); sum += c; cnt += (c > 0u) ? 1u : 0u; mine = (j == x) ? c : mine; }
        if (sum == G) break;
        __builtin_amdgcn_s_sleep(1);
        if ((++sp & 255u) == 0u) { if (xb_ld(&bar[XB_TMO])) break; if (sp > XB_SPIN_CAP) { atomicAdd(&bar[XB_TMO], 1u); break; } }
    }
    nloc = mine > 0u ? mine : 1u; nx = cnt > 0u ? cnt : 1u;
}

__device__ __forceinline__ void xcd_barrier(const XcdBarrier& b) {
    asm volatile("s_waitcnt vmcnt(0)" ::: "memory");
    __syncthreads();
    if (threadIdx.x == 0) {
        unsigned* bar = b.bar;
        __builtin_amdgcn_s_waitcnt(0);
        unsigned nloc = b.st[0], nx = b.st[1];
        if (nloc == 0u) { xcd_barrier_complete(bar, b.x, nloc, nx); b.st[0] = nloc; b.st[1] = nx; }
        const unsigned old = xb_add(&bar[XB_XSUB(b.x)], 1u);
        const unsigned gen = old / nloc;
        if (old + 1u == (gen + 1u) * nloc) {
            __builtin_amdgcn_fence(__ATOMIC_RELEASE, "agent");
            asm volatile("s_waitcnt vmcnt(0)" ::: "memory");
            const unsigned og = xb_add(&bar[XB_TOP], 1u);
            const unsigned tg = og / nx;
            if (og + 1u == (tg + 1u) * nx) xb_add(&bar[XB_TOPGEN], 1u);
            else XB_SPIN(xb_ld(&bar[XB_TOPGEN]) == tg, bar);
            __builtin_amdgcn_fence(__ATOMIC_ACQUIRE, "agent");
            xb_add(&bar[XB_XGEN(b.x)], 1u);
            asm volatile("s_waitcnt vmcnt(0)" ::: "memory");
        } else {
            XB_SPIN(xb_ld(&bar[XB_XGEN(b.x)]) == gen, bar);
            __builtin_amdgcn_fence(__ATOMIC_ACQUIRE, "agent");
            asm volatile("s_waitcnt vmcnt(0)" ::: "memory");
        }
    }
    __syncthreads();
}

struct Args { const float* in[17]; float* out; unsigned char* ws; };
struct Frame {
    LAS unsigned char* lds; volatile LAS unsigned* MISC; gu32* ctl;
    int wave, vcu, G;
    const float *xp, *xs, *cache_k, *cache_v, *cache_lf, *state_pool, *norm_gain, *w_in, *b_f, *qg, *kg, *w_pm, *pool_scale, *w_upp, *w_upa, *w_out; const int* page_table;
    float* out;
    unsigned char* ws;
};
__device__ __forceinline__ float wave_sum(float v) {
#pragma unroll
    for (int o = 1; o < 64; o <<= 1) v += __shfl_xor(v, o);
    return v;
}
__device__ __forceinline__ float wave_max(float v) {
#pragma unroll
    for (int o = 1; o < 64; o <<= 1) v = fmaxf(v, __shfl_xor(v, o));
    return v;
}
constexpr float LOG2E_ = 1.4426950408889634f;
__device__ __forceinline__ float bf_lo(unsigned u) { return __uint_as_float(u << 16); }
__device__ __forceinline__ float bf_hi(unsigned u) { return __uint_as_float(u & 0xffff0000u); }
__device__ __forceinline__ unsigned pkbf(float lo, float hi) { return pg8::cvt_pk_bf16(lo, hi); }
__device__ __forceinline__ unsigned pk4_u8(f32x4 v) { unsigned r = 0u;
    r = __builtin_amdgcn_cvt_pk_u8_f32(v[0], 0u, r); r = __builtin_amdgcn_cvt_pk_u8_f32(v[1], 1u, r); r = __builtin_amdgcn_cvt_pk_u8_f32(v[2], 2u, r); r = __builtin_amdgcn_cvt_pk_u8_f32(v[3], 3u, r); return r; }
__device__ __forceinline__ f32x4 un4_u8(unsigned w) { return (f32x4){(float)(w & 0xffu), (float)((w >> 8) & 0xffu), (float)((w >> 16) & 0xffu), (float)(w >> 24)} * (1.0f / 255.0f); }
__device__ __forceinline__ float sigmoidf_(float x) { return __builtin_amdgcn_rcpf(1.0f + __builtin_amdgcn_exp2f(-LOG2E_ * x)); }
__device__ __forceinline__ float siluf_(float x) { return x * __builtin_amdgcn_rcpf(1.0f + __builtin_amdgcn_exp2f(-LOG2E_ * x)); }
__device__ __forceinline__ float logsigmoidf_(float x) { return fminf(x, 0.f) - log1pf(expf(-fabsf(x))); }

__device__ __forceinline__ int rep_count(int n) { asm volatile("" : "+s"(n)); return n; }
struct TItem { const float* W; const float* gain; bf16* WT; int N, n0, k0, ldt, drow0, drow1; };
constexpr int TI_IN = (DMODEL / 64) * (NIN / 64), TI_PM = 4 * (256 / 64) * (256 / 64), TI_UP = (1024 / 64) * (DMODEL / 64), TI_OUT = (DMODEL / 64) * (DMODEL / 64), TI_ALL = TI_IN + TI_PM + 2 * TI_UP + TI_OUT;
__device__ __forceinline__ TItem p0_item(Frame& F, int it) {
    TItem t; int r = it;
    if (r < TI_IN) { const int kb = r / (NIN / 64), nb = r % (NIN / 64), pn = nb >> 2, wc = nb & 3;
        t.W = F.w_in; t.gain = F.norm_gain; t.WT = (bf16*)(F.ws + WS_WIN); t.N = INC; t.n0 = 256 * pn + 64 * wc + (pn >= 24 ? 16 : 0); t.k0 = 64 * kb; t.ldt = DMODEL; t.drow0 = 256 * pn + 32 * wc; t.drow1 = t.drow0 + 128; return t; } r -= TI_IN;
    t.gain = nullptr;
    if (r < TI_PM) { const int g = r >> 4, q = r & 15, kb = q >> 2, nb = q & 3; t.W = F.w_pm + (size_t)g * 65536; t.WT = (bf16*)(F.ws + WS_WPM) + (size_t)g * 65536; t.N = 256; t.n0 = 64 * nb; t.k0 = 64 * kb; t.ldt = 256; t.drow0 = 64 * nb; t.drow1 = t.drow0 + 32; return t; } r -= TI_PM;
    if (r < 2 * TI_UP) { const int half = r >= TI_UP; r -= half * TI_UP; const int kb = r / (DMODEL / 64), nb = r % (DMODEL / 64); t.W = half ? F.w_upa : F.w_upp; t.WT = (bf16*)(F.ws + WS_WUP) + 1024 * half; t.N = DMODEL; t.n0 = 64 * nb; t.k0 = 64 * kb; t.ldt = DMODEL; t.drow0 = 64 * nb; t.drow1 = t.drow0 + 32; return t; } r -= 2 * TI_UP;
    { const int kb = r / (DMODEL / 64), nb = r % (DMODEL / 64); t.W = F.w_out; t.WT = (bf16*)(F.ws + WS_WOUT); t.N = DMODEL; t.n0 = 64 * nb; t.k0 = 64 * kb; t.ldt = DMODEL; t.drow0 = 64 * nb; t.drow1 = t.drow0 + 32; return t; }
}
__device__ __forceinline__ void p0_item_load(const TItem& t, int lane, f32x4 (&v)[16]) {
    const GAS float* src = (const GAS float*)t.W + (size_t)(t.k0 + (lane >> 4)) * t.N + t.n0 + 4 * (lane & 15);
#pragma unroll
    for (int i = 0; i < 16; ++i) v[i] = __builtin_nontemporal_load((const GAS f32x4*)(src + (size_t)(4 * i) * t.N));
}
__device__ __forceinline__ void p0_item_store(const TItem& t, int lane, LAS float* scr, const f32x4 (&v)[16]) {
    const int kr = lane >> 4, c4 = lane & 15, c = lane & 7;
    f32x4 g0 = (f32x4){1.f, 1.f, 1.f, 1.f}, g1 = g0;
    if (t.gain) { g0 = *(const GAS f32x4*)(t.gain + t.k0 + 8 * c); g1 = *(const GAS f32x4*)(t.gain + t.k0 + 8 * c + 4); }
#pragma unroll
    for (int i = 0; i < 16; ++i) { LAS float* d = scr + (4 * i + kr) * 65 + 4 * c4; d[0] = v[i][0]; d[1] = v[i][1]; d[2] = v[i][2]; d[3] = v[i][3]; }
    LDS_WAIT(); asm volatile("" ::: "memory");
#pragma unroll
    for (int j = 0; j < 8; ++j) { const int n = (lane >> 3) + 8 * j; const LAS float* s = scr + (8 * c) * 65 + n; const int drow = (j < 4) ? t.drow0 + n : t.drow1 + (n - 32);
        v4u o; o.x = pkbf(s[0 * 65] * g0[0], s[1 * 65] * g0[1]); o.y = pkbf(s[2 * 65] * g0[2], s[3 * 65] * g0[3]); o.z = pkbf(s[4 * 65] * g1[0], s[5 * 65] * g1[1]); o.w = pkbf(s[6 * 65] * g1[2], s[7 * 65] * g1[3]);
        *(GAS v4u*)(t.WT + (size_t)drow * t.ldt + t.k0 + 8 * c) = o; }
    LDS_WAIT(); asm volatile("" ::: "memory");
}
__device__ __forceinline__ void p0_row_load(Frame& F, int m, int lane_, f32x4 (&v)[8]) {
    const float* xrow = (m < MP) ? F.xp + (size_t)m * DMODEL : F.xs + (size_t)(m - MP) * DMODEL;
    const GAS f32x4* xr = (const GAS f32x4*)xrow + lane_;
#pragma unroll
    for (int j = 0; j < 8; ++j) v[j] = __builtin_nontemporal_load(xr + 64 * j);
}
__device__ __forceinline__ void p0_row(Frame& F, int m, const LAS unsigned* WF, int lane_, const f32x4 (&v)[8], float bfh) {
    float ss = 0.f;
#pragma unroll
    for (int j = 0; j < 8; ++j) ss += (v[j].x * v[j].x + v[j].y * v[j].y) + (v[j].z * v[j].z + v[j].w * v[j].w);
    ss = wave_sum(ss);
    const float rinv = 1.0f / sqrtf(ss * (1.0f / DMODEL) + EPS);
    GAS unsigned long long* o8 = (GAS unsigned long long*)(((bf16*)(F.ws + WS_XB)) + (size_t)m * DMODEL) + lane_;
    float acc[16];
#pragma unroll
    for (int h = 0; h < 16; ++h) acc[h] = 0.f;
    typedef __bf16 bf16x2_t __attribute__((ext_vector_type(2)));
    typedef unsigned u32x2 __attribute__((ext_vector_type(2)));
#pragma unroll
    for (int j = 0; j < 8; ++j) {
        const unsigned p0 = pkbf(v[j].x, v[j].y), p1 = pkbf(v[j].z, v[j].w);
        o8[64 * j] = (unsigned long long)p0 | ((unsigned long long)p1 << 32);
#pragma unroll
        for (int h = 0; h < 16; ++h) { const unsigned wx = WF[h * 1024 + 128 * j + 2 * lane_], wy = WF[h * 1024 + 128 * j + 2 * lane_ + 1];
            acc[h] = __builtin_amdgcn_fdot2_f32_bf16(__builtin_bit_cast(bf16x2_t, p0), __builtin_bit_cast(bf16x2_t, wx), acc[h], false);
            acc[h] = __builtin_amdgcn_fdot2_f32_bf16(__builtin_bit_cast(bf16x2_t, p1), __builtin_bit_cast(bf16x2_t, wy), acc[h], false); }
    }
#pragma unroll
    for (int st = 0; st < 4; ++st) { const int s = 32 >> st, half = 8 >> st; const bool up = (lane_ & s) != 0;
#pragma unroll
        for (int i = 0; i < half; ++i) { const float send = up ? acc[i] : acc[i + half]; const float keep = up ? acc[i + half] : acc[i]; acc[i] = keep + __shfl_xor(send, s); } }
    float t = acc[0]; t += __shfl_xor(t, 2); t += __shfl_xor(t, 1);
    if ((lane_ & 3) == 0) { const int h = ((lane_ >> 5) & 1) * 8 + ((lane_ >> 4) & 1) * 4 + ((lane_ >> 3) & 1) * 2 + ((lane_ >> 2) & 1);
        const float lf = logsigmoidf_(t * rinv + bfh);
        if (m < MP) F.out[O_LFP + (size_t)m * NH + h] = lf; else F.out[O_LFS + (size_t)(m - MP) * NH + h] = lf; }
    if (lane_ == 0) ((float*)(F.ws + WS_RINV))[m] = rinv;
}
#ifndef FROWS
#define FROWS 1
#endif
constexpr int FUSED_CUS = NIN / 64;
__device__ __forceinline__ void p0_fused_in(Frame& F, int nb);
constexpr int TI_EARLY = TI_IN + TI_PM, LATE_CU0 = NIN / 64;
__device__ __forceinline__ void p0_items(Frame& F, int it0, int end, int stride, int lane_, LAS float* scr) {
    f32x4 va[16], vb[16]; int it = it0;
    TItem ta, tb; if (it < end) { ta = p0_item(F, it); p0_item_load(ta, lane_, va); }
    while (it < end) { int i2 = it + stride; if (i2 < end) { tb = p0_item(F, i2); p0_item_load(tb, lane_, vb); } p0_item_store(ta, lane_, scr, va); it = i2; if (it >= end) break;
        i2 = it + stride; if (i2 < end) { ta = p0_item(F, i2); p0_item_load(ta, lane_, va); } p0_item_store(tb, lane_, scr, vb); it = i2; }
}
__device__ __forceinline__ void p0_prologue(Frame& F) {
    const int tid_ = tid_fresh(), lane_ = tid_ & 63;
    LAS unsigned* WF = (LAS unsigned*)(F.lds + RING_OFF);
    const int gw = F.vcu * NWAVES + F.wave, NGW = F.G * NWAVES;
    const bool fused = (F.G == 256); const int bx_ = (int)blockIdx.x;
    const int RSTEP = fused ? (bx_ < FUSED_CUS ? FUSED_CUS * NWAVES : (256 - FUSED_CUS) * NWAVES) : NGW, REND = (fused && bx_ < FUSED_CUS) ? FROWS * FUSED_CUS * NWAVES : MT;
    f32x4 va[8], vb[8]; int m = fused ? (bx_ < FUSED_CUS ? bx_ * NWAVES + F.wave : FROWS * FUSED_CUS * NWAVES + (bx_ - FUSED_CUS) * NWAVES + F.wave) : gw;
    if (m < REND) p0_row_load(F, m, lane_, va);
    const float bfh = F.b_f[((lane_ >> 5) & 1) * 8 + ((lane_ >> 4) & 1) * 4 + ((lane_ >> 3) & 1) * 2 + ((lane_ >> 2) & 1)];
#pragma unroll
    for (int it = 0; it < 2; ++it) { const int i = tid_ + 512 * it;
        const GAS f32x4* r0 = (const GAS f32x4*)(F.w_in + (size_t)(2 * i) * INC + FLC); const GAS f32x4* r1 = (const GAS f32x4*)(F.w_in + (size_t)(2 * i + 1) * INC + FLC);
        f32x4 a[4], b[4];
#pragma unroll
        for (int q = 0; q < 4; ++q) { a[q] = r0[q]; b[q] = r1[q]; }
        const float ga = F.norm_gain[2 * i], gb = F.norm_gain[2 * i + 1];
#pragma unroll
        for (int q = 0; q < 4; ++q)
#pragma unroll
            for (int e = 0; e < 4; ++e) WF[(4 * q + e) * 1024 + i] = pkbf(a[q][e] * ga, b[q][e] * gb); }
    __syncthreads();
    if (m < REND) { const int m0_ = m; f32x4 vc[8];
        { const int mm = m + RSTEP; p0_row_load(F, mm < REND ? mm : m0_, lane_, vb); }
        for (;;) { { const int mm = m + 2 * RSTEP; p0_row_load(F, mm < REND ? mm : m0_, lane_, vc); } p0_row(F, m, WF, lane_, va, bfh); m += RSTEP; if (m >= REND) break;
            { const int mm = m + 2 * RSTEP; p0_row_load(F, mm < REND ? mm : m0_, lane_, va); } p0_row(F, m, WF, lane_, vb, bfh); m += RSTEP; if (m >= REND) break;
            { const int mm = m + 2 * RSTEP; p0_row_load(F, mm < REND ? mm : m0_, lane_, vb); } p0_row(F, m, WF, lane_, vc, bfh); m += RSTEP; if (m >= REND) break; } }
    for (int it = gw; it < DB * NPG; it += NGW) { const int phys = F.page_table[it]; const GAS f32x4* src = (const GAS f32x4*)(F.cache_lf + (size_t)phys * PAGE * NH) + lane_;
        f32x4 s = src[0];
#pragma unroll
        for (int i = 1; i < 8; ++i) s += src[64 * i];
#pragma unroll
        for (int o = 4; o < 64; o <<= 1) { s.x += __shfl_xor(s.x, o); s.y += __shfl_xor(s.y, o); s.z += __shfl_xor(s.z, o); s.w += __shfl_xor(s.w, o); }
        if (lane_ < 4) *(GAS f32x4*)(((float*)(F.ws + WS_PSUM)) + (size_t)it * NH + 4 * lane_) = s; }
    for (int it = gw; it < DB * 7; it += NGW) { const int b = it / 7, r = it % 7; const GAS f32x4* src = (const GAS f32x4*)(F.state_pool + (size_t)(b * PBUF + r + 8) * PW) + lane_;
        GAS f32x4* dst = (GAS f32x4*)(F.out + O_PS + (size_t)(b * PBUF + r) * PW) + lane_;
#pragma unroll
        for (int i = 0; i < 4; ++i) dst[64 * i] = src[64 * i]; }
    __syncthreads();
    LAS float* scr = (LAS float*)(F.lds + F.wave * 16640);
    if (!fused) { p0_items(F, gw, (F.G > LATE_CU0) ? TI_EARLY : TI_ALL, NGW, lane_, scr); return; }
    p0_items(F, TI_IN + gw, TI_EARLY, NGW, lane_, scr);
    if (bx_ < FUSED_CUS) p0_fused_in(F, bx_);
}
__device__ __forceinline__ void p0_late_items(Frame& F, int bx) {
    const int tid_ = tid_fresh(), lane_ = tid_ & 63;
    LAS float* scr = (LAS float*)(F.lds + F.wave * 16640);
    if (F.G == 256) p0_items(F, TI_EARLY + bx * NWAVES + F.wave, TI_ALL, 256 * NWAVES, lane_, scr);
    else p0_items(F, TI_EARLY + (bx - LATE_CU0) * NWAVES + F.wave, TI_ALL, (F.G - LATE_CU0) * NWAVES, lane_, scr);
    __syncthreads();
}

using pg8::Unit; using pg8::f32x4;
typedef unsigned u32x4 __attribute__((ext_vector_type(4)));
__device__ __forceinline__ void st8_bf16(bf16* p, f32x4 a, f32x4 b) { u32x4 w; w.x = pkbf(a[0], a[1]); w.y = pkbf(a[2], a[3]); w.z = pkbf(b[0], b[1]); w.w = pkbf(b[2], b[3]); *(GAS u32x4*)p = w; }
__device__ __forceinline__ void st8_f32(float* p, f32x4 a, f32x4 b) { *(GAS f32x4*)p = a; *(GAS f32x4*)(p + 4) = b; }
__device__ __forceinline__ void ld8_bf16(const bf16* p, f32x4& a, f32x4& b) { const u32x4 w = *(const GAS u32x4*)p; a = (f32x4){bf_lo(w.x), bf_hi(w.x), bf_lo(w.y), bf_hi(w.y)}; b = (f32x4){bf_lo(w.z), bf_hi(w.z), bf_lo(w.w), bf_hi(w.w)}; }

struct SchedIn {
    int G, c, i0, i1; const char* A; const char* B;
    __device__ __forceinline__ bool next(int i, Unit& u) const { if (i0 + i >= i1 || !pg8::static_tile(i0 + i, G, c, MP / 256, NIN / 256, u.pm, u.pn)) return false; u.aux = 0;
        u.a = A + (size_t)u.pm * 256 * DMODEL * 2; u.b = B + (size_t)u.pn * 256 * DMODEL * 2; return true; }
    __device__ __forceinline__ void a_ready(const Unit&) const {} __device__ __forceinline__ void done(const Unit&) const {}
};
struct SchedPool {
    int G, c; const char* A; const char* B;
    __device__ __forceinline__ bool next(int i, Unit& u) const { const int L = i * G + c; if (L >= (MP / 256) * 8) return false; u.pm = L >> 3; u.pn = (L >> 1) & 3; u.aux = L & 1;
        u.a = A + ((size_t)u.pm * 256 * PW + 256 * u.pn) * 2; u.b = B + ((size_t)u.pn * 65536 + (size_t)u.aux * 128 * 256) * 2; return true; }
    __device__ __forceinline__ void a_ready(const Unit&) const {} __device__ __forceinline__ void done(const Unit&) const {}
};
struct SchedUp {
    int G, c; const char* A; const char* B;
    __device__ __forceinline__ bool next(int i, Unit& u) const { if (!pg8::static_tile(i, G, c, MP / 256, DMODEL / 256, u.pm, u.pn)) return false; u.aux = 0;
        u.a = A + (size_t)u.pm * 256 * DMODEL * 2; u.b = B + (size_t)u.pn * 256 * DMODEL * 2; return true; }
    __device__ __forceinline__ void a_ready(const Unit&) const {} __device__ __forceinline__ void done(const Unit&) const {}
};
struct SchedOut {
    int G, c; const char* A; const char* B;
    __device__ __forceinline__ bool next(int i, Unit& u) const { if (!pg8::static_tile(i, G, c, MP / 256, DMODEL / 256, u.pm, u.pn)) return false; u.aux = 0;
        u.a = A + (size_t)u.pm * 256 * DMODEL * 2; u.b = B + (size_t)u.pn * 256 * DMODEL * 2; return true; }
    __device__ __forceinline__ void a_ready(const Unit&) const {} __device__ __forceinline__ void done(const Unit&) const {}
};

struct EpiIn {
    static constexpr int ID = 1; static constexpr bool PERM = true, AFTER_DRAIN = false, HAS_MID = false, HAS_PF = false;
    const float* rinv; bf16 *U, *GP, *Q, *KB, *VB, *GA; unsigned char *MA8, *MB8; float *kout, *vout, *pool; const float *qg, *kg;
    __device__ __forceinline__ void operator()(const f32x4 (&acc)[2][2][4][2], const Unit& u, int wr, int wc, int, int) const {
        const int l_ = tid_fresh() & 63, fr = l_ & 15, fq = l_ >> 4;
        const int pn = u.pn, region = pn < 24 ? (pn >> 2) : (pn < 32 ? 6 : 7);
        int row0 = u.pm * 256 + wr * 64 + fr; asm volatile("" : "+v"(row0));
        const int cb = (pn < 24 ? 256 * (pn & 3) : 256 * ((pn - 24) & 7)) + 64 * wc + 8 * fq;
        float rvs[2][4];
#pragma unroll
        for (int ai = 0; ai < 2; ++ai)
#pragma unroll
            for (int m = 0; m < 4; ++m) rvs[ai][m] = rinv[row0 + ai * 128 + m * 16];
        __builtin_amdgcn_sched_barrier(0);
        if (region == 2 || region == 3) {
            const float* gn = (region == 2) ? qg : kg; const float sc = (region == 2) ? C2 : 1.0f;
            f32x4 g0[2], g1[2];
#pragma unroll
            for (int bj = 0; bj < 2; ++bj) { g0[bj] = *(const GAS f32x4*)(gn + 32 * bj + 8 * fq) * sc; g1[bj] = *(const GAS f32x4*)(gn + 32 * bj + 8 * fq + 4) * sc; }
#pragma unroll
            for (int ai = 0; ai < 2; ++ai)
#pragma unroll
                for (int m = 0; m < 4; ++m) { const int row = row0 + ai * 128 + m * 16; const float rv = rvs[ai][m];
                    f32x4 v[2][2]; float ss = 0.f;
#pragma unroll
                    for (int bj = 0; bj < 2; ++bj)
#pragma unroll
                        for (int n = 0; n < 2; ++n) { v[bj][n] = acc[ai][bj][m][n] * rv; const f32x4 x = v[bj][n]; ss += (x[0] * x[0] + x[1] * x[1]) + (x[2] * x[2] + x[3] * x[3]); }
                    ss += __shfl_xor(ss, 16); ss += __shfl_xor(ss, 32);
                    const float r = __builtin_amdgcn_rsqf(ss * (1.0f / 64.0f) + EPS);
#pragma unroll
                    for (int bj = 0; bj < 2; ++bj) { const f32x4 a = v[bj][0] * r * g0[bj], b = v[bj][1] * r * g1[bj]; const size_t off = (size_t)row * AW + cb + 32 * bj;
                        if (region == 2) st8_bf16(Q + off, a, b); else { st8_f32(kout + off, a, b); st8_bf16(KB + off, a, b); } } }
            return;
        }
#pragma unroll
        for (int ai = 0; ai < 2; ++ai)
#pragma unroll
            for (int m = 0; m < 4; ++m) { const int row = row0 + ai * 128 + m * 16; const float rv = rvs[ai][m];
#pragma unroll
                for (int bj = 0; bj < 2; ++bj) { f32x4 a = acc[ai][bj][m][0] * rv, b = acc[ai][bj][m][1] * rv; const int col = cb + 32 * bj;
                    if (region == 0) { st8_bf16(U + (size_t)row * PW + col, a, b); const int t = row & (SEQ - 1); if (t >= SEQ - PBUF) st8_f32(pool + ((size_t)(row >> 11) * PBUF + (t - (SEQ - PBUF))) * PW + col, a, b); }
                    else if (region == 4) { st8_f32(vout + (size_t)row * AW + col, a, b); st8_bf16(VB + (size_t)row * AW + col, a, b); }
                    else if (region == 1 || region == 5) {
#pragma unroll
                        for (int e = 0; e < 4; ++e) { a[e] = siluf_(a[e]); b[e] = siluf_(b[e]); }
                        st8_bf16((region == 1 ? GP : GA) + (size_t)row * AW + col, a, b); }
                    else {
#pragma unroll
                        for (int e = 0; e < 4; ++e) { a[e] = sigmoidf_(a[e]) * 255.0f; b[e] = sigmoidf_(b[e]) * 255.0f; }
                        typedef unsigned u32x2s __attribute__((ext_vector_type(2)));
                        *(GAS u32x2s*)((region == 6 ? MA8 : MB8) + (size_t)row * DMODEL + col) = (u32x2s){pk4_u8(a), pk4_u8(b)}; } } }
    }
};
struct EpiPool {
    static constexpr int ID = 2; static constexpr bool PERM = true, AFTER_DRAIN = false, HAS_MID = false, HAS_PF = false;
    const float* scale; const bf16* GP; bf16* AB;
    __device__ __forceinline__ void operator()(const f32x4 (&acc)[2][2][4][2], const Unit& u, int wr, int wc, int, int) const {
        const int l_ = tid_fresh() & 63, fr = l_ & 15, fq = l_ >> 4;
        int row0 = u.pm * 256 + wr * 64 + fr, c0 = u.pn * 256 + u.aux * 128 + wc * 32 + 8 * fq; asm volatile("" : "+v"(row0), "+v"(c0));
        const f32x4 s0 = *(const GAS f32x4*)(scale + c0), s1 = *(const GAS f32x4*)(scale + c0 + 4);
        u32x4 gv[2][4];
#pragma unroll
        for (int ai = 0; ai < 2; ++ai)
#pragma unroll
            for (int m = 0; m < 4; ++m) gv[ai][m] = *(const GAS u32x4*)(GP + (size_t)(row0 + ai * 128 + m * 16) * PW + c0);
        __builtin_amdgcn_sched_barrier(0);
#pragma unroll
        for (int ai = 0; ai < 2; ++ai)
#pragma unroll
            for (int m = 0; m < 4; ++m) { const u32x4 w = gv[ai][m]; const f32x4 ga = (f32x4){bf_lo(w.x), bf_hi(w.x), bf_lo(w.y), bf_hi(w.y)}, gb = (f32x4){bf_lo(w.z), bf_hi(w.z), bf_lo(w.w), bf_hi(w.w)};
                st8_bf16(AB + (size_t)(row0 + ai * 128 + m * 16) * DMODEL + c0, acc[ai][0][m][0] * s0 * ga, acc[ai][0][m][1] * s1 * gb); }
    }
};
struct EpiUp {
    static constexpr int ID = 4; static constexpr bool PERM = true, AFTER_DRAIN = false, HAS_MID = true, HAS_PF = false;
    const unsigned char *MA8, *MB8; bf16* MG;
    __device__ __forceinline__ const unsigned char* pf(int it, const Unit& u, int wid, int lane) const { const int L = (it < 3 ? it : 3) * 256 + wid * 32 + (lane >> 1), rem = L & 511;
        return ((L >> 9) ? MB8 : MA8) + (size_t)(u.pm * 256 + (rem >> 1)) * DMODEL + u.pn * 256 + (rem & 1) * 128; }
    typedef unsigned u32x2s __attribute__((ext_vector_type(2)));
    __device__ __forceinline__ void mid(f32x4 (&acc)[2][2][4][2], const Unit& u, int wr, int wc) const {
        const int l_ = tid_fresh() & 63, fr = l_ & 15, fq = l_ >> 4;
        int row0 = u.pm * 256 + wr * 64 + fr, c0 = u.pn * 256 + wc * 32 + 8 * fq; asm volatile("" : "+v"(row0), "+v"(c0));
#pragma unroll
        for (int ai = 0; ai < 2; ++ai) { u32x2s ga[4][2], gb[4][2];
#pragma unroll
            for (int m = 0; m < 4; ++m)
#pragma unroll
                for (int bj = 0; bj < 2; ++bj) { const size_t off = (size_t)(row0 + ai * 128 + m * 16) * DMODEL + c0 + 128 * bj; ga[m][bj] = *(const GAS u32x2s*)(MA8 + off); gb[m][bj] = *(const GAS u32x2s*)(MB8 + off); }
            __builtin_amdgcn_sched_barrier(0);
#pragma unroll
            for (int m = 0; m < 4; ++m)
#pragma unroll
                for (int bj = 0; bj < 2; ++bj) { const f32x4 a0 = un4_u8(ga[m][bj].x), a1 = un4_u8(ga[m][bj].y), b0 = un4_u8(gb[m][bj].x), b1 = un4_u8(gb[m][bj].y);
#pragma unroll
                    for (int e = 0; e < 4; ++e) { acc[ai][bj][m][0][e] *= a0[e] * __builtin_amdgcn_rcpf(fmaxf(b0[e], 1.0e-20f)); acc[ai][bj][m][1][e] *= a1[e] * __builtin_amdgcn_rcpf(fmaxf(b1[e], 1.0e-20f)); } }
            __builtin_amdgcn_sched_barrier(0); }
    }
    __device__ __forceinline__ void operator()(const f32x4 (&acc)[2][2][4][2], const Unit& u, int wr, int wc, int, int) const {
        const int l_ = tid_fresh() & 63, fr = l_ & 15, fq = l_ >> 4;
        int row0 = u.pm * 256 + wr * 64 + fr, c0 = u.pn * 256 + wc * 32 + 8 * fq; asm volatile("" : "+v"(row0), "+v"(c0));
        u32x2s gv[2][4][2];
#pragma unroll
        for (int ai = 0; ai < 2; ++ai)
#pragma unroll
            for (int m = 0; m < 4; ++m)
#pragma unroll
                for (int bj = 0; bj < 2; ++bj) gv[ai][m][bj] = *(const GAS u32x2s*)(MB8 + (size_t)(row0 + ai * 128 + m * 16) * DMODEL + c0 + 128 * bj);
        __builtin_amdgcn_sched_barrier(0);
#pragma unroll
        for (int ai = 0; ai < 2; ++ai)
#pragma unroll
            for (int m = 0; m < 4; ++m)
#pragma unroll
                for (int bj = 0; bj < 2; ++bj) { f32x4 s0 = un4_u8(gv[ai][m][bj].x), s1 = un4_u8(gv[ai][m][bj].y);
#pragma unroll
                    for (int e = 0; e < 4; ++e) { s0[e] = fmaxf(s0[e], 1.0e-20f); s1[e] = fmaxf(s1[e], 1.0e-20f); }
                    st8_bf16(MG + (size_t)(row0 + ai * 128 + m * 16) * DMODEL + c0 + 128 * bj, acc[ai][bj][m][0] * s0, acc[ai][bj][m][1] * s1); }
    }
};
struct EpiOut {
    static constexpr int ID = 8; static constexpr bool PERM = false, AFTER_DRAIN = true, HAS_MID = false, HAS_PF = true;
    const float* x; float* y;
    __device__ __forceinline__ const float* pf(int it, const Unit& u, int wid, int lane) const { const int L = it * 128 + wid * 16 + (lane >> 2); return x + (size_t)(u.pm * 256 + (L >> 3)) * DMODEL + u.pn * 256 + (L & 7) * 32; }
    __device__ __forceinline__ void operator()(const f32x4 (&acc)[2][2][4][2], const Unit& u, int wr, int wc, int, int) const {
        const int l_ = tid_fresh() & 63, fr = l_ & 15, fq = l_ >> 4;
        int row0 = u.pm * 256 + wr * 64 + fr, c0 = u.pn * 256 + wc * 32 + 4 * fq; asm volatile("" : "+v"(row0), "+v"(c0));
#pragma unroll 1
        for (int ai = 0; ai < 2; ++ai)
#pragma unroll
            for (int m = 0; m < 4; ++m)
#pragma unroll
                for (int bj = 0; bj < 2; ++bj) { const size_t off = (size_t)(row0 + ai * 128 + m * 16) * DMODEL + c0 + 128 * bj;
                    const f32x4 xa = *(const GAS f32x4*)(x + off), xb = *(const GAS f32x4*)(x + off + 16);
                    *(GAS f32x4*)(y + off) = xa + (ai ? acc[1][bj][m][0] : acc[0][bj][m][0]); *(GAS f32x4*)(y + off + 16) = xb + (ai ? acc[1][bj][m][1] : acc[0][bj][m][1]); }
    }
    __device__ __forceinline__ void fused(const f32x4 (&acc)[2][2][4][2], const Unit& u, int wr, int wc, int, int, LAS unsigned char* lds, int wid, int) const {
        const int l_ = tid_fresh() & 63, fr = l_ & 15, fq = l_ >> 4;
        int wbase = (wr * 64 + fr) * 1024, rbase = wid * 16 * 1024; asm volatile("" : "+v"(wbase));
#pragma unroll
        for (int ai = 0; ai < 2; ++ai) {
            const size_t g0 = (size_t)(u.pm * 256 + ai * 128 + wid * 16) * DMODEL + u.pn * 256 + 4 * l_;
            f32x4 xa[8], xb[8];
#pragma unroll
            for (int j = 0; j < 8; ++j) xa[j] = *(const GAS f32x4*)(x + g0 + (size_t)j * DMODEL);
#pragma unroll
            for (int m = 0; m < 4; ++m)
#pragma unroll
                for (int bj = 0; bj < 2; ++bj)
#pragma unroll
                    for (int n = 0; n < 2; ++n) *(LAS f32x4*)(lds + wbase + m * 16384 + (((32 * bj + 8 * wc + 4 * n + fq) ^ fr) << 4)) = acc[ai][bj][m][n];
            __syncthreads();
#pragma unroll
            for (int j = 0; j < 8; ++j) xb[j] = *(const GAS f32x4*)(x + g0 + (size_t)(8 + j) * DMODEL);
            __builtin_amdgcn_sched_barrier(0);
#pragma unroll
            for (int j = 0; j < 8; ++j) { const f32x4 v = *(const LAS f32x4*)(lds + rbase + j * 1024 + ((l_ ^ j) << 4)); __builtin_nontemporal_store(xa[j] + v, (GAS f32x4*)(y + g0 + (size_t)j * DMODEL)); }
            __builtin_amdgcn_sched_barrier(0);
#pragma unroll
            for (int j = 0; j < 8; ++j) { const f32x4 v = *(const LAS f32x4*)(lds + rbase + (8 + j) * 1024 + ((l_ ^ (8 + j)) << 4)); __builtin_nontemporal_store(xb[j] + v, (GAS f32x4*)(y + g0 + (size_t)(8 + j) * DMODEL)); }
            __syncthreads();
        }
    }
};

template <int W> __device__ __forceinline__ void pool_diff_rows(Frame& F, int row, int c0) {
    const bf16* U = (const bf16*)(F.ws + WS_U); f32x4 ua, ub; ld8_bf16(U + (size_t)row * PW + c0, ua, ub); f32x4 sa = ua, sb = ub;
    const int t = row & (SEQ - 1); f32x4 a[W - 1], b[W - 1];
#pragma unroll
    for (int j = 1; j < W; ++j) { a[j - 1] = (f32x4){0.f, 0.f, 0.f, 0.f}; b[j - 1] = a[j - 1]; if (j <= t) ld8_bf16(U + (size_t)(row - j) * PW + c0, a[j - 1], b[j - 1]); }
#pragma unroll
    for (int j = 1; j < W; ++j) { sa += a[j - 1]; sb += b[j - 1]; }
    const int nw = (t + 1 < W) ? t + 1 : W; const float inv = 1.0f / (float)nw;
    st8_bf16((bf16*)(F.ws + WS_D) + (size_t)row * PW + c0, sa * inv - ua, sb * inv - ub);
}
template <int W> __device__ __forceinline__ void pool_diff_tile_w(Frame& F, int pm, int g, int tid_) {
    const bf16* U = (const bf16*)(F.ws + WS_U); bf16* D = (bf16*)(F.ws + WS_D);
    const int c0 = 256 * g + 8 * (tid_ & 31), rb = 256 * pm + 16 * (tid_ >> 5), t0 = rb & (SEQ - 1);
    u32x4 u[15 + W];
#pragma unroll
    for (int j = 0; j < 15 + W; ++j) { u[j] = (u32x4){0u, 0u, 0u, 0u}; if (t0 + j - (W - 1) >= 0) u[j] = *(const GAS u32x4*)(U + (size_t)(rb + j - (W - 1)) * PW + c0); }
    f32x4 sa = (f32x4){0.f, 0.f, 0.f, 0.f}, sb = sa;
#pragma unroll
    for (int j = 0; j < W - 1; ++j) { const u32x4 w = u[j]; sa += (f32x4){bf_lo(w.x), bf_hi(w.x), bf_lo(w.y), bf_hi(w.y)}; sb += (f32x4){bf_lo(w.z), bf_hi(w.z), bf_lo(w.w), bf_hi(w.w)}; }
#pragma unroll
    for (int i = 0; i < 16; ++i) { const u32x4 w = u[i + W - 1]; const f32x4 ua = (f32x4){bf_lo(w.x), bf_hi(w.x), bf_lo(w.y), bf_hi(w.y)}, ub = (f32x4){bf_lo(w.z), bf_hi(w.z), bf_lo(w.w), bf_hi(w.w)};
        sa += ua; sb += ub;
        const int t = t0 + i, nw = (t + 1 < W) ? t + 1 : W; const float inv = 1.0f / (float)nw;
        st8_bf16(D + (size_t)(rb + i) * PW + c0, sa * inv - ua, sb * inv - ub);
        const u32x4 o = u[i]; sa -= (f32x4){bf_lo(o.x), bf_hi(o.x), bf_lo(o.y), bf_hi(o.y)}; sb -= (f32x4){bf_lo(o.z), bf_hi(o.z), bf_lo(o.w), bf_hi(o.w)}; }
}
__device__ __forceinline__ void pool_diff_tile(Frame& F, int pm, int g) {
    const int tid_ = tid_fresh();
    if (g == 0) pool_diff_tile_w<2>(F, pm, g, tid_); else if (g == 1) pool_diff_tile_w<4>(F, pm, g, tid_); else if (g == 2) pool_diff_tile_w<8>(F, pm, g, tid_); else pool_diff_tile_w<16>(F, pm, g, tid_);
    asm volatile("s_waitcnt vmcnt(0)" ::: "memory"); __syncthreads();
}
constexpr int PL_D = 0, PL_B = 65536;
template <int W> __device__ __forceinline__ void pool_diff_lds_w(Frame& F, int pm2, int g, int tid_) {
    const bf16* U = (const bf16*)(F.ws + WS_U);
    const int chunk = tid_ & 31, rl = 8 * (tid_ >> 5), c0 = 256 * g + 8 * chunk, rb = 128 * pm2 + rl, t0 = rb & (SEQ - 1);
    u32x4 u[7 + W];
#pragma unroll
    for (int j = 0; j < 7 + W; ++j) { u[j] = (u32x4){0u, 0u, 0u, 0u}; if (t0 + j - (W - 1) >= 0) u[j] = *(const GAS u32x4*)(U + (size_t)(rb + j - (W - 1)) * PW + c0); }
    f32x4 sa = (f32x4){0.f, 0.f, 0.f, 0.f}, sb = sa;
#pragma unroll
    for (int j = 0; j < W - 1; ++j) { const u32x4 w = u[j]; sa += (f32x4){bf_lo(w.x), bf_hi(w.x), bf_lo(w.y), bf_hi(w.y)}; sb += (f32x4){bf_lo(w.z), bf_hi(w.z), bf_lo(w.w), bf_hi(w.w)}; }
#pragma unroll
    for (int i = 0; i < 8; ++i) { const u32x4 w = u[i + W - 1]; const f32x4 ua = (f32x4){bf_lo(w.x), bf_hi(w.x), bf_lo(w.y), bf_hi(w.y)}, ub = (f32x4){bf_lo(w.z), bf_hi(w.z), bf_lo(w.w), bf_hi(w.w)};
        sa += ua; sb += ub;
        const int t = t0 + i, nw = (t + 1 < W) ? t + 1 : W; const float inv = 1.0f / (float)nw;
        const f32x4 a = sa * inv - ua, b = sb * inv - ub; u32x4 o; o.x = pkbf(a[0], a[1]); o.y = pkbf(a[2], a[3]); o.z = pkbf(b[0], b[1]); o.w = pkbf(b[2], b[3]);
        *(LAS u32x4*)(F.lds + PL_D + (rl + i) * 512 + ((chunk ^ ((rl + i) & 15)) << 4)) = o;
        const u32x4 x = u[i]; sa -= (f32x4){bf_lo(x.x), bf_hi(x.x), bf_lo(x.y), bf_hi(x.y)}; sb -= (f32x4){bf_lo(x.z), bf_hi(x.z), bf_lo(x.w), bf_hi(x.w)}; }
}
__device__ __forceinline__ void pool_b_load(Frame& F, int g, int nh, int tid_, u32x4 (&bv)[8]) {
#pragma unroll
    for (int i = 0; i < 8; ++i) { const int idx = i * 512 + tid_, sl = idx >> 5, chunk = idx & 31, col = 32 * (sl >> 5) + pg8::perm32(sl & 31);
        bv[i] = *(const GAS u32x4*)(((const bf16*)(F.ws + WS_WPM)) + (size_t)g * 65536 + (size_t)(128 * nh + col) * 256 + 8 * chunk); }
}
__device__ __forceinline__ void pool_b_store(Frame& F, int tid_, const u32x4 (&bv)[8]) {
#pragma unroll
    for (int i = 0; i < 8; ++i) { const int idx = i * 512 + tid_, sl = idx >> 5, chunk = idx & 31; *(LAS u32x4*)(F.lds + PL_B + sl * 512 + ((chunk ^ (sl & 15)) << 4)) = bv[i]; }
}
__device__ __forceinline__ void pool_mma_epi(Frame& F, int pm2, int g, int nh, int tid_) {
    const int lane = tid_ & 63, r = lane & 15, g4 = lane >> 4, w = F.wave, wm = w & 3, wn = w >> 2;
    f32x4 acc[2][2][2];
#pragma unroll
    for (int mb = 0; mb < 2; ++mb)
#pragma unroll
        for (int q = 0; q < 2; ++q) { acc[mb][q][0] = (f32x4){0.f, 0.f, 0.f, 0.f}; acc[mb][q][1] = acc[mb][q][0]; }
    const LAS unsigned char* ap = F.lds + PL_D + (32 * wm + r) * 512; const LAS unsigned char* bp = F.lds + PL_B + (64 * wn + r) * 512;
#pragma unroll
    for (int ks = 0; ks < 8; ++ks) { const int co = ((4 * ks + g4) ^ r) << 4;
        bf16x8 af[2], bfq[2][2];
#pragma unroll
        for (int mb = 0; mb < 2; ++mb) af[mb] = *(const LAS bf16x8*)(ap + mb * 16 * 512 + co);
#pragma unroll
        for (int q = 0; q < 2; ++q)
#pragma unroll
            for (int n = 0; n < 2; ++n) bfq[q][n] = *(const LAS bf16x8*)(bp + (32 * q + 16 * n) * 512 + co);
#pragma unroll
        for (int mb = 0; mb < 2; ++mb)
#pragma unroll
            for (int q = 0; q < 2; ++q)
#pragma unroll
                for (int n = 0; n < 2; ++n) acc[mb][q][n] = __builtin_amdgcn_mfma_f32_16x16x32_bf16(bfq[q][n], af[mb], acc[mb][q][n], 0, 0, 0); }
    const bf16* GP = (const bf16*)(F.ws + WS_GP); bf16* AB = (bf16*)(F.ws + WS_AB);
#pragma unroll
    for (int q = 0; q < 2; ++q) { const int c0 = 256 * g + 128 * nh + 64 * wn + 32 * q + 8 * g4;
        const f32x4 s0 = *(const GAS f32x4*)(F.pool_scale + c0), s1 = *(const GAS f32x4*)(F.pool_scale + c0 + 4);
#pragma unroll
        for (int mb = 0; mb < 2; ++mb) { const size_t row = (size_t)(128 * pm2 + 32 * wm + 16 * mb + r); f32x4 ga, gb; ld8_bf16(GP + row * PW + c0, ga, gb);
            st8_bf16(AB + row * DMODEL + c0, acc[mb][q][0] * s0 * ga, acc[mb][q][1] * s1 * gb); } }
}
__device__ __forceinline__ void pool_unit_lds(Frame& F, int unit) {
    const int tid_ = tid_fresh(), g = (unit >> 1) & 3, pm2 = 2 * (unit >> 3) + (unit & 1);
    u32x4 bv[8]; pool_b_load(F, g, 0, tid_, bv);
    if (g == 0) pool_diff_lds_w<2>(F, pm2, g, tid_); else if (g == 1) pool_diff_lds_w<4>(F, pm2, g, tid_); else if (g == 2) pool_diff_lds_w<8>(F, pm2, g, tid_); else pool_diff_lds_w<16>(F, pm2, g, tid_);
    pool_b_store(F, tid_, bv);
    __syncthreads();
    pool_b_load(F, g, 1, tid_, bv);
    pool_mma_epi(F, pm2, g, 0, tid_);
    __syncthreads();
    pool_b_store(F, tid_, bv);
    __syncthreads();
    pool_mma_epi(F, pm2, g, 1, tid_);
    __syncthreads();
}
template <int W> __device__ __forceinline__ void pool_diff_sample_w(Frame& F, int g, int tid_) {
    const bf16* U = (const bf16*)(F.ws + WS_U); bf16* D = (bf16*)(F.ws + WS_D);
    const int b8 = tid_ >> 5, c0 = 256 * g + 8 * (tid_ & 31);
    f32x4 za[W - 1 + 8], zb[W - 1 + 8];
#pragma unroll
    for (int j = 0; j < W - 1; ++j) { const float* sp = F.state_pool + ((size_t)b8 * PBUF + PBUF - (W - 1) + j) * PW + c0; za[j] = *(const GAS f32x4*)sp; zb[j] = *(const GAS f32x4*)(sp + 4); }
#pragma unroll
    for (int i = 0; i < 8; ++i) ld8_bf16(U + (size_t)(MP + b8 * DS + i) * PW + c0, za[W - 1 + i], zb[W - 1 + i]);
    f32x4 sa = (f32x4){0.f, 0.f, 0.f, 0.f}, sb = sa;
#pragma unroll
    for (int j = 0; j < W - 1; ++j) { sa += za[j]; sb += zb[j]; }
    const float inv = 1.0f / (float)W;
#pragma unroll
    for (int i = 0; i < 8; ++i) { sa += za[W - 1 + i]; sb += zb[W - 1 + i];
        st8_bf16(D + (size_t)(MP + b8 * DS + i) * PW + c0, sa * inv - za[W - 1 + i], sb * inv - zb[W - 1 + i]);
        sa -= za[i]; sb -= zb[i]; }
}
__device__ __forceinline__ void pool_diff_sample(Frame& F, int g) {
    const int tid_ = tid_fresh();
    if (tid_ < 256) { if (g == 0) pool_diff_sample_w<2>(F, g, tid_); else if (g == 1) pool_diff_sample_w<4>(F, g, tid_); else if (g == 2) pool_diff_sample_w<8>(F, g, tid_); else pool_diff_sample_w<16>(F, g, tid_); }
    asm volatile("s_waitcnt vmcnt(0)" ::: "memory"); __syncthreads();
}
__device__ __forceinline__ void q_publish(Frame& F) {
    asm volatile("s_waitcnt vmcnt(0)" ::: "memory"); __syncthreads();
    if (threadIdx.x == 0) { __builtin_amdgcn_fence(__ATOMIC_RELEASE, "agent"); asm volatile("s_waitcnt vmcnt(0)" ::: "memory");
        __hip_atomic_fetch_add(F.ctl + CW_QFLAG, 1u, __ATOMIC_RELAXED, __HIP_MEMORY_SCOPE_AGENT); }
}
__device__ __forceinline__ void q_wait(Frame& F) {
    if (threadIdx.x == 0) { unsigned sp = 0;
        while (__hip_atomic_load(F.ctl + CW_QFLAG, __ATOMIC_RELAXED, __HIP_MEMORY_SCOPE_AGENT) < 16u) { __builtin_amdgcn_s_sleep(4);
            if (++sp > (1u << 22)) { __hip_atomic_store(F.ctl + CW_TMO, 1u, __ATOMIC_RELAXED, __HIP_MEMORY_SCOPE_AGENT); break; } }
        __builtin_amdgcn_fence(__ATOMIC_ACQUIRE, "agent"); asm volatile("s_waitcnt vmcnt(0)" ::: "memory"); }
    __syncthreads();
}

constexpr int SK_PITCH = 68, SK_TILE = 64 * SK_PITCH * 4;
template <int K, class BRow> __device__ __forceinline__ void skinny_mma(const bf16* A, int lda, int ldb, const BRow& brow, LAS unsigned char* lds, int wave, int tid, f32x4& ra, f32x4& rb) {
    const int lane = tid & 63, r = lane & 15, g = lane >> 4; constexpr int KW = K / 8, NKS = KW / 32, BATCH = NKS < 4 ? NKS : 4;
    const GAS bf16* ap = (const GAS bf16*)A + (size_t)r * lda + wave * KW + 8 * g;
    const GAS bf16* bp[4];
#pragma unroll
    for (int nb = 0; nb < 4; ++nb) bp[nb] = (const GAS bf16*)brow(nb) + (size_t)r * ldb + wave * KW + 8 * g;
    f32x4 acc[4][4];
#pragma unroll
    for (int mb = 0; mb < 4; ++mb)
#pragma unroll
        for (int nb = 0; nb < 4; ++nb) acc[mb][nb] = (f32x4){0.f, 0.f, 0.f, 0.f};
#pragma unroll
    for (int k0 = 0; k0 < NKS; k0 += BATCH) { bf16x8 af[BATCH][4], bf[BATCH][4];
#pragma unroll
        for (int ks = 0; ks < BATCH; ++ks)
#pragma unroll
            for (int q = 0; q < 4; ++q) { af[ks][q] = *(const GAS bf16x8*)(ap + (size_t)(16 * q) * lda + 32 * (k0 + ks)); bf[ks][q] = *(const GAS bf16x8*)(bp[q] + 32 * (k0 + ks)); }
        __builtin_amdgcn_sched_barrier(0);
#pragma unroll
        for (int ks = 0; ks < BATCH; ++ks)
#pragma unroll
            for (int mb = 0; mb < 4; ++mb)
#pragma unroll
                for (int nb = 0; nb < 4; ++nb) acc[mb][nb] = __builtin_amdgcn_mfma_f32_16x16x32_bf16(af[ks][mb], bf[ks][nb], acc[mb][nb], 0, 0, 0); }
    LAS float* tile = (LAS float*)(lds + wave * SK_TILE);
#pragma unroll
    for (int mb = 0; mb < 4; ++mb)
#pragma unroll
        for (int nb = 0; nb < 4; ++nb)
#pragma unroll
            for (int i = 0; i < 4; ++i) tile[(16 * mb + 4 * g + i) * SK_PITCH + 16 * nb + r] = acc[mb][nb][i];
    __syncthreads();
    const int srow = tid >> 3, cg = tid & 7; ra = (f32x4){0.f, 0.f, 0.f, 0.f}; rb = ra;
#pragma unroll
    for (int w = 0; w < 8; ++w) { const LAS f32x4* p = (const LAS f32x4*)(lds + w * SK_TILE + (srow * SK_PITCH + 8 * cg) * 4); ra += p[0]; rb += p[1]; }
    __syncthreads();
}

__device__ __forceinline__ void sample_in_epilogue(Frame& F, int su, int tid_, f32x4 a, f32x4 b, float rv);
__device__ __forceinline__ void sample_in_unit(Frame& F, int su) {
    const int tid_ = tid_fresh(), lane_ = tid_ & 63;
    const int pn = su >> 2, wcu = su & 3, region = su >> 4;
    const bf16* Bbase = ((bf16*)(F.ws + WS_WIN)) + (size_t)(256 * pn + 32 * wcu) * DMODEL;
    auto brow = [&](int nb) { return Bbase + (size_t)(128 * (nb >> 1) + 16 * (nb & 1)) * DMODEL; };
    f32x4 a, b; skinny_mma<DMODEL>(((bf16*)(F.ws + WS_XB)) + (size_t)MP * DMODEL, DMODEL, DMODEL, brow, F.lds, F.wave, tid_, a, b);
    sample_in_epilogue(F, su, tid_, a, b, ((float*)(F.ws + WS_RINV))[MP + (tid_ >> 3)]);
    __syncthreads();
}
__device__ __forceinline__ void sample_in_epilogue(Frame& F, int su, int tid_, f32x4 a, f32x4 b, float rv) {
    const int region = su >> 4, srow = tid_ >> 3, cg = tid_ & 7, row = MP + srow;
    a = a * rv; b = b * rv;
    const int col = 64 * (su & 15) + 8 * cg;
    if (region == 0) { st8_bf16(((bf16*)(F.ws + WS_U)) + (size_t)row * PW + col, a, b); st8_f32(F.out + O_PS + ((size_t)(srow >> 3) * PBUF + 7 + (srow & 7)) * PW + col, a, b); }
    else if (region == 1 || region == 5) {
#pragma unroll
        for (int e = 0; e < 4; ++e) { a[e] = siluf_(a[e]); b[e] = siluf_(b[e]); }
        st8_bf16((region == 1 ? ((bf16*)(F.ws + WS_GP)) : ((bf16*)(F.ws + WS_GA))) + (size_t)row * AW + col, a, b); }
    else if (region == 2 || region == 3) {
        float ss = (a[0] * a[0] + a[1] * a[1]) + (a[2] * a[2] + a[3] * a[3]) + (b[0] * b[0] + b[1] * b[1]) + (b[2] * b[2] + b[3] * b[3]);
        ss += __shfl_xor(ss, 1); ss += __shfl_xor(ss, 2); ss += __shfl_xor(ss, 4);
        const float r = 1.0f / sqrtf(ss * (1.0f / 64.0f) + EPS); const float* gn = (region == 2) ? F.qg : F.kg; const float sc = (region == 2) ? C2 : 1.0f;
        const f32x4 g0 = *(const GAS f32x4*)(gn + 8 * cg), g1 = *(const GAS f32x4*)(gn + 8 * cg + 4);
        a = a * r * g0 * sc; b = b * r * g1 * sc;
        if (region == 2) st8_bf16(((bf16*)(F.ws + WS_Q)) + (size_t)row * AW + col, a, b); else { st8_f32(F.out + O_KS + (size_t)srow * AW + col, a, b); st8_bf16(((bf16*)(F.ws + WS_KB)) + (size_t)row * AW + col, a, b); } }
    else if (region == 4) { st8_f32(F.out + O_VS + (size_t)srow * AW + col, a, b); st8_bf16(((bf16*)(F.ws + WS_VB)) + (size_t)row * AW + col, a, b); }
    else { const int col2 = 64 * ((su - 96) & 31) + 8 * cg;
#pragma unroll
        for (int e = 0; e < 4; ++e) { a[e] = sigmoidf_(a[e]); b[e] = sigmoidf_(b[e]); }
        st8_bf16((su < 128 ? ((bf16*)(F.ws + WS_MA)) : ((bf16*)(F.ws + WS_MB))) + (size_t)row * DMODEL + col2, a, b); }
}
__device__ __forceinline__ void p0_fused_in(Frame& F, int nb) {
    const int tid_ = tid_fresh(), lane = tid_ & 63, r = lane & 15, g4 = lane >> 4, w = F.wave;
    LAS float* scr = (LAS float*)(F.lds + w * 16640);
    f32x4 acc[4][4]; float ss[4];
#pragma unroll
    for (int mb = 0; mb < 4; ++mb) { ss[mb] = 0.f;
#pragma unroll
        for (int nbk = 0; nbk < 4; ++nbk) acc[mb][nbk] = (f32x4){0.f, 0.f, 0.f, 0.f}; }
    TItem t = p0_item(F, w * (NIN / 64) + nb);
    f32x4 v[16]; p0_item_load(t, lane, v);
#pragma unroll 1
    for (int i = 0; i < 4; ++i) {
        f32x4 xa[4][2][2];
#pragma unroll
        for (int mb = 0; mb < 4; ++mb)
#pragma unroll
            for (int half = 0; half < 2; ++half) { const GAS f32x4* px = (const GAS f32x4*)(F.xs + (size_t)(16 * mb + r) * DMODEL + t.k0 + 32 * half + 8 * g4); xa[mb][half][0] = px[0]; xa[mb][half][1] = px[1]; }
        { const int kr = lane >> 4, c4 = lane & 15;
#pragma unroll
            for (int i2 = 0; i2 < 16; ++i2) { LAS float* d = scr + (4 * i2 + kr) * 65 + 4 * c4; d[0] = v[i2][0]; d[1] = v[i2][1]; d[2] = v[i2][2]; d[3] = v[i2][3]; } }
        bf16x8 af[4][2];
#pragma unroll
        for (int mb = 0; mb < 4; ++mb)
#pragma unroll
            for (int half = 0; half < 2; ++half) { const f32x4 p = xa[mb][half][0], q = xa[mb][half][1];
                ss[mb] += (p[0] * p[0] + p[1] * p[1]) + (p[2] * p[2] + p[3] * p[3]) + (q[0] * q[0] + q[1] * q[1]) + (q[2] * q[2] + q[3] * q[3]);
                u32x4 o; o.x = pkbf(p[0], p[1]); o.y = pkbf(p[2], p[3]); o.z = pkbf(q[0], q[1]); o.w = pkbf(q[2], q[3]); af[mb][half] = __builtin_bit_cast(bf16x8, o); }
        const TItem tc = t;
        if (i + 1 < 4) { t = p0_item(F, (w + 8 * (i + 1)) * (NIN / 64) + nb); p0_item_load(t, lane, v); }
        LDS_WAIT(); asm volatile("" ::: "memory");
#pragma unroll
        for (int half = 0; half < 2; ++half) { const int kk = 32 * half + 8 * g4;
            const f32x4 g0 = *(const GAS f32x4*)(tc.gain + tc.k0 + kk), g1 = *(const GAS f32x4*)(tc.gain + tc.k0 + kk + 4);
#pragma unroll
            for (int nbk = 0; nbk < 4; ++nbk) { const int n = 16 * nbk + r; const LAS float* sp = scr + kk * 65 + n; const int drow = (nbk < 2) ? tc.drow0 + n : tc.drow1 + (n - 32);
                u32x4 o; o.x = pkbf(sp[0 * 65] * g0[0], sp[1 * 65] * g0[1]); o.y = pkbf(sp[2 * 65] * g0[2], sp[3 * 65] * g0[3]); o.z = pkbf(sp[4 * 65] * g1[0], sp[5 * 65] * g1[1]); o.w = pkbf(sp[6 * 65] * g1[2], sp[7 * 65] * g1[3]);
                *(GAS u32x4*)(tc.WT + (size_t)drow * tc.ldt + tc.k0 + kk) = o;
                const bf16x8 bfr = __builtin_bit_cast(bf16x8, o);
#pragma unroll
                for (int mb = 0; mb < 4; ++mb) acc[mb][nbk] = __builtin_amdgcn_mfma_f32_16x16x32_bf16(af[mb][half], bfr, acc[mb][nbk], 0, 0, 0); } }
        LDS_WAIT(); asm volatile("" ::: "memory");
    }
#pragma unroll
    for (int mb = 0; mb < 4; ++mb) { ss[mb] += __shfl_xor(ss[mb], 16); ss[mb] += __shfl_xor(ss[mb], 32); }
    __syncthreads();
    LAS float* tile = (LAS float*)(F.lds + w * SK_TILE); LAS float* ssl = (LAS float*)(F.lds + 8 * SK_TILE);
#pragma unroll
    for (int mb = 0; mb < 4; ++mb)
#pragma unroll
        for (int nbk = 0; nbk < 4; ++nbk)
#pragma unroll
            for (int i = 0; i < 4; ++i) tile[(16 * mb + 4 * g4 + i) * SK_PITCH + 16 * nbk + r] = acc[mb][nbk][i];
    if (g4 == 0) {
#pragma unroll
        for (int mb = 0; mb < 4; ++mb) ssl[w * 64 + 16 * mb + r] = ss[mb]; }
    __syncthreads();
    const int srow = tid_ >> 3, cg = tid_ & 7; f32x4 ra = (f32x4){0.f, 0.f, 0.f, 0.f}, rb = ra; float sst = 0.f;
#pragma unroll
    for (int ww = 0; ww < 8; ++ww) { const LAS f32x4* p = (const LAS f32x4*)(F.lds + ww * SK_TILE + (srow * SK_PITCH + 8 * cg) * 4); ra += p[0]; rb += p[1]; sst += ssl[ww * 64 + srow]; }
    sample_in_epilogue(F, nb, tid_, ra, rb, 1.0f / sqrtf(sst * (1.0f / DMODEL) + EPS));
    __syncthreads();
}
__device__ __forceinline__ void sample_pool_unit(Frame& F, int j) {
    const int tid_ = tid_fresh(), lane_ = tid_ & 63;
    const int g = j >> 2, q4 = j & 3; const bf16* Bbase = ((bf16*)(F.ws + WS_WPM)) + (size_t)g * 65536 + (size_t)(64 * q4) * 256;
    pool_diff_sample(F, g);
    auto brow = [&](int nb) { return Bbase + (size_t)(16 * nb) * 256; };
    f32x4 a, b, ga, gb; skinny_mma<256>(((bf16*)(F.ws + WS_D)) + (size_t)MP * PW + 256 * g, PW, 256, brow, F.lds, F.wave, tid_, a, b);
    const int srow = tid_ >> 3, cg = tid_ & 7, row = MP + srow, col = 256 * g + 64 * q4 + 8 * cg;
    const f32x4 s0 = *(const GAS f32x4*)(F.pool_scale + col), s1 = *(const GAS f32x4*)(F.pool_scale + col + 4); ld8_bf16(((bf16*)(F.ws + WS_GP)) + (size_t)row * PW + col, ga, gb);
    st8_bf16(((bf16*)(F.ws + WS_AB)) + (size_t)row * DMODEL + col, a * s0 * ga, b * s1 * gb);
    __syncthreads();
}
constexpr int SK16_TILE = 16 * 33 * 4;
__device__ __forceinline__ void skinny16(const bf16* A, const bf16* B, LAS unsigned char* lds, int wave, int tid, float& lo, float& hi) {
    const int lane = tid & 63, r = lane & 15, g = lane >> 4;
    const GAS bf16* ap = (const GAS bf16*)A + (size_t)r * DMODEL + wave * 256 + 8 * g;
    const GAS bf16* bp = (const GAS bf16*)B + (size_t)r * DMODEL + wave * 256 + 8 * g;
    bf16x8 af[8], b0[8], b1[8];
#pragma unroll
    for (int ks = 0; ks < 8; ++ks) { af[ks] = *(const GAS bf16x8*)(ap + 32 * ks); b0[ks] = *(const GAS bf16x8*)(bp + 32 * ks); b1[ks] = *(const GAS bf16x8*)(bp + (size_t)16 * DMODEL + 32 * ks); }
    __builtin_amdgcn_sched_barrier(0);
    f32x4 acc0 = (f32x4){0.f, 0.f, 0.f, 0.f}, acc1 = acc0;
#pragma unroll
    for (int ks = 0; ks < 8; ++ks) { acc0 = __builtin_amdgcn_mfma_f32_16x16x32_bf16(af[ks], b0[ks], acc0, 0, 0, 0); acc1 = __builtin_amdgcn_mfma_f32_16x16x32_bf16(af[ks], b1[ks], acc1, 0, 0, 0); }
    LAS float* tile = (LAS float*)(lds + wave * SK16_TILE);
#pragma unroll
    for (int i = 0; i < 4; ++i) { tile[(4 * g + i) * 33 + r] = acc0[i]; tile[(4 * g + i) * 33 + 16 + r] = acc1[i]; }
    __syncthreads();
    const int e = (tid >> 5) * 33 + (tid & 31); lo = 0.f; hi = 0.f;
#pragma unroll
    for (int w = 0; w < 4; ++w) { lo += ((const LAS float*)(lds + w * SK16_TILE))[e]; hi += ((const LAS float*)(lds + (4 + w) * SK16_TILE))[e]; }
    __syncthreads();
}
__device__ __forceinline__ void sample_up_sub(Frame& F, int id) {
    const int tid_ = tid_fresh(), rg = (id >> 3) & 3, cgp = (id & 7) + 8 * (id >> 5);
    float lo, hi; skinny16(((bf16*)(F.ws + WS_AB)) + (size_t)(MP + 16 * rg) * DMODEL, ((bf16*)(F.ws + WS_WUP)) + (size_t)(32 * cgp) * DMODEL, F.lds, F.wave, tid_, lo, hi);
    const size_t o = (size_t)(MP + 16 * rg + (tid_ >> 5)) * DMODEL + 32 * cgp + (tid_ & 31);
    const float ma = bf_lo(((const GAS bf16*)(F.ws + WS_MA))[o]), mb = bf_lo(((const GAS bf16*)(F.ws + WS_MB))[o]);
    ((GAS bf16*)(F.ws + WS_MG))[o] = (bf16)(pkbf(lo * ma + hi * mb, 0.f) & 0xffffu);
}
__device__ __forceinline__ void sample_out_sub(Frame& F, int id) {
    const int tid_ = tid_fresh(), rg = (id >> 3) & 3, cgp = (id & 7) + 8 * (id >> 5);
    float lo, hi; skinny16(((bf16*)(F.ws + WS_MG)) + (size_t)(MP + 16 * rg) * DMODEL, ((bf16*)(F.ws + WS_WOUT)) + (size_t)(32 * cgp) * DMODEL, F.lds, F.wave, tid_, lo, hi);
    const size_t o = (size_t)(16 * rg + (tid_ >> 5)) * DMODEL + 32 * cgp + (tid_ & 31);
    ((GAS float*)(F.out + O_YS))[o] = ((const GAS float*)F.xs)[o] + (lo + hi);
}
__device__ __forceinline__ void sample_up_unit(Frame& F, int j) {
    const int tid_ = tid_fresh(), lane_ = tid_ & 63;
    const bf16* B0 = ((bf16*)(F.ws + WS_WUP)) + (size_t)(64 * j) * DMODEL; const bf16* B1 = B0 + 1024;
    auto brow0 = [&](int nb) { return B0 + (size_t)(16 * nb) * DMODEL; }; auto brow1 = [&](int nb) { return B1 + (size_t)(16 * nb) * DMODEL; };
    f32x4 a, b, c, d, ma, mb2, na, nb2;
    skinny_mma<1024>(((bf16*)(F.ws + WS_AB)) + (size_t)MP * DMODEL, DMODEL, DMODEL, brow0, F.lds, F.wave, tid_, a, b);
    skinny_mma<1024>(((bf16*)(F.ws + WS_AB)) + (size_t)MP * DMODEL + 1024, DMODEL, DMODEL, brow1, F.lds, F.wave, tid_, c, d);
    const int srow = tid_ >> 3, cg = tid_ & 7, row = MP + srow, col = 64 * j + 8 * cg;
    ld8_bf16(((bf16*)(F.ws + WS_MA)) + (size_t)row * DMODEL + col, ma, mb2); ld8_bf16(((bf16*)(F.ws + WS_MB)) + (size_t)row * DMODEL + col, na, nb2);
    st8_bf16(((bf16*)(F.ws + WS_MG)) + (size_t)row * DMODEL + col, a * ma + c * na, b * mb2 + d * nb2);
    __syncthreads();
}
__device__ __forceinline__ void sample_out_unit(Frame& F, int j) {
    const int tid_ = tid_fresh(), lane_ = tid_ & 63;
    const bf16* B0 = ((bf16*)(F.ws + WS_WOUT)) + (size_t)(64 * j) * DMODEL; auto brow = [&](int nb) { return B0 + (size_t)(16 * nb) * DMODEL; };
    f32x4 a, b; skinny_mma<DMODEL>(((bf16*)(F.ws + WS_MG)) + (size_t)MP * DMODEL, DMODEL, DMODEL, brow, F.lds, F.wave, tid_, a, b);
    const int srow = tid_ >> 3, cg = tid_ & 7, col = 64 * j + 8 * cg;
    const f32x4 xa = *(const GAS f32x4*)(F.xs + (size_t)srow * DMODEL + col), xb = *(const GAS f32x4*)(F.xs + (size_t)srow * DMODEL + col + 4);
    st8_f32(F.out + O_YS + (size_t)srow * DMODEL + col, xa + a, xb + b);
    __syncthreads();
}

constexpr float NEGBIG = -1.0e30f;
#ifndef DEC_AUX
#define DEC_AUX 18
#endif
typedef float f32x2_cv __attribute__((ext_vector_type(2))); typedef __bf16 bf16x2_cv __attribute__((ext_vector_type(2)));
__device__ __forceinline__ unsigned pkbf_c(float lo, float hi) { f32x2_cv v = {lo, hi}; bf16x2_cv b = __builtin_convertvector(v, bf16x2_cv); return __builtin_bit_cast(unsigned, b); }
__device__ __forceinline__ float xg_max(float x) {
    auto s = __builtin_amdgcn_permlane16_swap(__float_as_uint(x), __float_as_uint(x), false, false); x = fmaxf(__uint_as_float(s[0]), __uint_as_float(s[1]));
    auto t = __builtin_amdgcn_permlane32_swap(__float_as_uint(x), __float_as_uint(x), false, false); return fmaxf(__uint_as_float(t[0]), __uint_as_float(t[1])); }
constexpr int DEC_VPITCH = 160, DEC_IMG = 32 * DEC_VPITCH, DEC_WAVE_LDS = 4096 + 2 * DEC_IMG;
typedef short v4i16_t __attribute__((ext_vector_type(4)));
template <bool PROBE = false> __device__ __forceinline__ void decode_partials(Frame& F) {
    const int tid_ = tid_fresh(), lane_ = tid_ & 63;
    const int c = F.vcu; if (c >= DB * 32) return;
    const int b = c >> 5, sp = c & 31, lane = lane_, n = lane & 15, g = lane >> 4, w = F.wave;
    LAS float* btab = (LAS float*)(F.lds + w * DEC_WAVE_LDS);
    LAS unsigned char* kimg = F.lds + w * DEC_WAVE_LDS + 4096; LAS unsigned char* vimg = kimg + DEC_IMG;
    int phys[4];
#pragma unroll
    for (int p = 0; p < 4; ++p) phys[p] = __builtin_amdgcn_readfirstlane(F.page_table[b * NPG + sp + 32 * p]);
    typedef unsigned u32x2 __attribute__((ext_vector_type(2)));
#pragma unroll
    for (int hh = 0; hh < 2; ++hh) { const int h = w + 8 * hh;
        const float* ps = ((float*)(F.ws + WS_PSUM)) + (size_t)b * NPG * NH + h; const float x0 = ps[(size_t)lane * NH], x1 = ps[(size_t)(lane + 64) * NH];
#pragma unroll
        for (int p = 0; p < 4; ++p) { const int pg = sp + 32 * p; const float later = wave_sum(((lane > pg) ? x0 : 0.f) + ((lane + 64 > pg) ? x1 : 0.f));
            const float* lf = F.cache_lf + (size_t)phys[p] * PAGE * NH + h; const float a = lf[(size_t)(2 * lane) * NH], bq = lf[(size_t)(2 * lane + 1) * NH];
            float inc = a + bq;
#pragma unroll
            for (int o = 1; o < 64; o <<= 1) { const float y = __shfl_down(inc, o); if (lane + o < 64) inc += y; }
            const float ex = inc - (a + bq);
            btab[(p * 2 + hh) * 128 + 2 * lane] = (later + ex + bq) * LOG2E; btab[(p * 2 + hh) * 128 + 2 * lane + 1] = (later + ex) * LOG2E; }
    }
    LDS_WAIT();
    const __amdgpu_buffer_rsrc_t rsk = __builtin_amdgcn_make_buffer_rsrc((void*)F.cache_k, 0, (int)((size_t)1280 * PAGE * NH * HD * 4), 0x00020000);
    const __amdgpu_buffer_rsrc_t rsv = __builtin_amdgcn_make_buffer_rsrc((void*)F.cache_v, 0, (int)((size_t)1280 * PAGE * NH * HD * 4), 0x00020000);
    const int iwr = (lane >> 4) * DEC_VPITCH + 8 * (lane & 15);
    const int krd = n * DEC_VPITCH + 16 * g;
    const int vrd = (4 * g + ((lane & 15) >> 2)) * DEC_VPITCH + 8 * (lane & 3);
    for (int hh = 0; hh < 2; ++hh) { const int h = w + 8 * hh;
        bf16x8 qf[2];
        { const bf16* qrow = ((bf16*)(F.ws + WS_Q)) + (size_t)(MP + b * DS + (n & 7)) * AW + h * HD;
#pragma unroll
            for (int half = 0; half < 2; ++half) { u32x4 qv = *(const GAS u32x4*)(qrow + 32 * half + 8 * g); if (n >= 8) qv = (u32x4){0u, 0u, 0u, 0u}; qf[half] = __builtin_bit_cast(bf16x8, qv); } }
        float mrun = NEGBIG, lrun = 0.f; f32x4 o[4];
#pragma unroll
        for (int mb = 0; mb < 4; ++mb) o[mb] = (f32x4){0.f, 0.f, 0.f, 0.f};
#define DEC_BASE(j_) (((size_t)phys[PROBE ? 3 - (((j_) >> 2) & 1) : 3 - ((j_) >> 2)] * PAGE * NH + h) * HD + (size_t)(32 * ((j_) & 3) + (lane >> 4)) * (NH * HD) + 4 * (lane & 15))
#define DEC_ISSUE_K(j_, KK) do { const unsigned ob_ = (unsigned)(DEC_BASE(j_) * 4); \
        _Pragma("unroll") for (int r_ = 0; r_ < 8; ++r_) KK[r_] = __builtin_bit_cast(f32x4, __builtin_amdgcn_raw_buffer_load_b128(rsk, ob_ + (unsigned)(r_ * NH * HD * 16), 0, DEC_AUX)); } while (0)
#define DEC_ISSUE_V(j_, VV) do { const unsigned ob_ = (unsigned)(DEC_BASE(j_) * 4); \
        _Pragma("unroll") for (int r_ = 0; r_ < 8; ++r_) VV[r_] = __builtin_bit_cast(f32x4, __builtin_amdgcn_raw_buffer_load_b128(rsv, ob_ + (unsigned)(r_ * NH * HD * 16), 0, DEC_AUX)); } while (0)
#define DEC_PK4(X) pkbf_c(X[0], X[1]), pkbf_c(X[2], X[3])
#define DEC_S(j_, KK, PF, AL, ND) do { \
        _Pragma("unroll") for (int r_ = 0; r_ < 8; ++r_) *(LAS u32x2*)(kimg + iwr + 4 * r_ * DEC_VPITCH) = (u32x2){DEC_PK4(KK[r_])}; \
        if ((j_) + 2 < 16) DEC_ISSUE_K((j_) + 2, KK); \
        const LAS float* bt_ = btab + ((3 - ((j_) >> 2)) * 2 + hh) * 128 + 32 * ((j_) & 3); \
        f32x4 sA = *(const LAS f32x4*)(bt_ + 4 * g), sB = *(const LAS f32x4*)(bt_ + 16 + 4 * g); \
        _Pragma("unroll") for (int half = 0; half < 2; ++half) { \
            const bf16x8 fa = *(const LAS bf16x8*)(kimg + krd + 64 * half), fb = *(const LAS bf16x8*)(kimg + krd + 16 * DEC_VPITCH + 64 * half); \
            sA = __builtin_amdgcn_mfma_f32_16x16x32_bf16(fa, qf[half], sA, 0, 0, 0); sB = __builtin_amdgcn_mfma_f32_16x16x32_bf16(fb, qf[half], sB, 0, 0, 0); } \
        float bm = fmaxf(fmaxf(fmaxf(sA[0], sA[1]), fmaxf(sA[2], sA[3])), fmaxf(fmaxf(sB[0], sB[1]), fmaxf(sB[2], sB[3]))); \
        bm = xg_max(bm); \
        const float mnew = fmaxf(mrun, bm); AL = __builtin_amdgcn_exp2f(mrun - mnew); mrun = mnew; \
        float pa[4], pb[4], psum = 0.f; \
        _Pragma("unroll") for (int i_ = 0; i_ < 4; ++i_) { pa[i_] = __builtin_amdgcn_exp2f(sA[i_] - mnew); pb[i_] = __builtin_amdgcn_exp2f(sB[i_] - mnew); psum += pa[i_] + pb[i_]; } \
        lrun = lrun * AL + psum; \
        ND = __any((n < 8) && (psum != 0.f)) != 0;     \
        PF = (u32x4){pkbf_c(pa[0], pa[1]), pkbf_c(pa[2], pa[3]), pkbf_c(pb[0], pb[1]), pkbf_c(pb[2], pb[3])}; } while (0)
#define DEC_PV(j_, VV, PF, AL, ND, ND2) do { \
        if (ND) { _Pragma("unroll") for (int r_ = 0; r_ < 8; ++r_) *(LAS u32x2*)(vimg + iwr + 4 * r_ * DEC_VPITCH) = (u32x2){DEC_PK4(VV[r_])}; } \
        if ((j_) + 2 < 16 && (ND2)) DEC_ISSUE_V((j_) + 2, VV); \
        _Pragma("unroll") for (int mb = 0; mb < 4; ++mb) o[mb] = o[mb] * AL; \
        if (ND) { _Pragma("unroll") for (int mb = 0; mb < 4; ++mb) { \
            const v4i16_t t0 = __builtin_amdgcn_ds_read_tr16_b64_v4i16((LAS v4i16_t*)(vimg + vrd + 32 * mb)), t1 = __builtin_amdgcn_ds_read_tr16_b64_v4i16((LAS v4i16_t*)(vimg + vrd + 16 * DEC_VPITCH + 32 * mb)); \
            const bf16x8 vf = (bf16x8){t0[0], t0[1], t0[2], t0[3], t1[0], t1[1], t1[2], t1[3]}; \
            o[mb] = __builtin_amdgcn_mfma_f32_16x16x32_bf16(vf, __builtin_bit_cast(bf16x8, PF), o[mb], 0, 0, 0); } } } while (0)
        f32x4 kA[8], kB[8], vA[8], vB[8]; u32x4 pf0, pf1, pf2; float al0, al1, al2 = 1.f; bool nd0, nd1, nd2 = false;
        pf2 = (u32x4){0u, 0u, 0u, 0u};
        DEC_ISSUE_K(0, kA); DEC_ISSUE_K(1, kB);
        DEC_S(0, kA, pf0, al0, nd0); if (nd0) DEC_ISSUE_V(0, vA);
        DEC_S(1, kB, pf1, al1, nd1); if (nd1) DEC_ISSUE_V(1, vB);
        for (int j = 0; j < 16; j += 2) {
            if (j + 2 < 16) DEC_S(j + 2, kA, pf2, al2, nd2);
            DEC_PV(j, vA, pf0, al0, nd0, nd2);
            pf0 = pf2; al0 = al2; nd0 = nd2;
            if (j + 3 < 16) DEC_S(j + 3, kB, pf2, al2, nd2);
            DEC_PV(j + 1, vB, pf1, al1, nd1, nd2);
            pf1 = pf2; al1 = al2; nd1 = nd2;
        }
#undef DEC_BASE
#undef DEC_ISSUE_K
#undef DEC_ISSUE_V
#undef DEC_S
#undef DEC_PV
#undef DEC_PK4
        float l = lrun; l += __shfl_xor(l, 16); l += __shfl_xor(l, 32);
        if (!PROBE && n < 8) { const size_t rec = ((size_t)(b * NH + h) * 32 + sp) * 8 + n; float* PML = (float*)(F.ws + WS_PML); float* PO = (float*)(F.ws + WS_PO);
            if (g == 0) { PML[rec * 2] = mrun; PML[rec * 2 + 1] = l; }
#pragma unroll
            for (int mb = 0; mb < 4; ++mb) *(GAS f32x4*)(PO + rec * 64 + 16 * mb + 4 * g) = o[mb]; }
    }
}
__device__ __forceinline__ void decode_combine(Frame& F, int job) {
    const int tid_ = tid_fresh(), lane = tid_ & 63;
    const int bh = job >> 3, q = job & 7, b = bh >> 4, h = bh & 15;
    const float* PML = (const float*)(F.ws + WS_PML); const float* PO = (const float*)(F.ws + WS_PO);
    const bf16* Qb = (const bf16*)(F.ws + WS_Q); const bf16* KBb = (const bf16*)(F.ws + WS_KB); const bf16* VBb = (const bf16*)(F.ws + WS_VB);
    const size_t rec0 = (size_t)bh * 32 * 8;
    float po[32];
#pragma unroll
    for (int s = 0; s < 32; ++s) po[s] = PO[(rec0 + (size_t)s * 8 + q) * 64 + lane];
    const float pm = (lane < 32) ? PML[(rec0 + (size_t)lane * 8 + q) * 2] : NEGBIG, pl = (lane < 32) ? PML[(rec0 + (size_t)lane * 8 + q) * 2 + 1] : 0.f;
    float kd[8], vd[8], lfn[8];
#pragma unroll
    for (int i = 0; i < 8; ++i) { kd[i] = __uint_as_float((unsigned)KBb[(size_t)(MP + b * DS + i) * AW + h * HD + lane] << 16); vd[i] = __uint_as_float((unsigned)VBb[(size_t)(MP + b * DS + i) * AW + h * HD + lane] << 16);
        lfn[i] = F.out[O_LFS + (size_t)(b * DS + i) * NH + h]; }
    const float qd = __uint_as_float((unsigned)Qb[(size_t)(MP + b * DS + q) * AW + h * HD + lane] << 16);
    float xs[8], run = 0.f;
#pragma unroll
    for (int s = 0; s < 8; ++s) { run += lfn[s]; xs[s] = (s <= q) ? wave_sum(qd * kd[s]) - run * LOG2E : NEGBIG; }
    float mt = wave_max(pm);
#pragma unroll
    for (int s = 0; s < 8; ++s) mt = fmaxf(mt, xs[s]);
    const float sc = __builtin_amdgcn_exp2f(pm - mt);
    float lt = wave_sum(pl * sc), od = 0.f;
#pragma unroll
    for (int s = 0; s < 8; ++s) { const float p = (s <= q) ? __builtin_amdgcn_exp2f(xs[s] - mt) : 0.f; lt += p; od += p * vd[s]; }
#pragma unroll
    for (int s = 0; s < 32; ++s) od += __shfl(sc, s) * po[s];
    const size_t row = MP + b * DS + q; const float gate = __uint_as_float((unsigned)((const bf16*)(F.ws + WS_GA))[row * AW + h * HD + lane] << 16);
    const float r = od / lt * gate;
    ((bf16*)(F.ws + WS_AB))[row * DMODEL + 1024 + h * HD + lane] = (unsigned short)(pkbf(r, r) & 0xffffu);
}
#ifdef DIAG
__device__ __forceinline__ float diag_rinv(const float* xrow, int lane) { float ss = 0.f; for (int k = lane; k < DMODEL; k += 64) ss += xrow[k] * xrow[k]; ss = wave_sum(ss); return 1.0f / sqrtf(ss * (1.0f / DMODEL) + EPS); }
__device__ __forceinline__ float diag_proj(Frame& F, const float* xrow, int col0, int lane, int ncol) { float acc = 0.f; if (lane < ncol) for (int k = 0; k < DMODEL; ++k) acc += xrow[k] * F.norm_gain[k] * F.w_in[(size_t)k * INC + col0 + lane]; return acc; }
__device__ __forceinline__ bool diag_cmp(float ref, float got, int lane, int ncol) { float d = (lane < ncol) ? (ref - got) * (ref - got) : 0.f, r = (lane < ncol) ? ref * ref : 0.f; d = wave_sum(d); r = wave_sum(r); return !(d <= 1e-3f * r + 1e-12f); }
__device__ __forceinline__ void diag_phase(Frame& F) {
    if (blockIdx.x != 0) return;
    const int tid_ = tid_fresh(), lane = tid_ & 63, w = F.wave;
    const int rows[3] = {0, 3000, 8191}, heads[3] = {0, 9, 15}, srows[3] = {0, 37, 63};
    bool bad[8] = {false, false, false, false, false, false, false, false};
    for (int ci = w; ci < 9; ci += 8) { const int ri = ci / 3, hi = ci % 3, h = heads[hi];
        { const int row = rows[ri]; const float* xr = F.xp + (size_t)row * DMODEL; const float r = diag_rinv(xr, lane);
            float kq = diag_proj(F, xr, 3072 + 64 * h, lane, 64) * r; float ss = wave_sum(kq * kq); kq = kq / sqrtf(ss * (1.0f / 64.0f) + EPS) * F.kg[lane];
            bad[0] |= diag_cmp(kq, F.out[O_KP + (size_t)row * AW + 64 * h + lane], lane, 64);
            const float vv = diag_proj(F, xr, 4096 + 64 * h, lane, 64) * r; bad[1] |= diag_cmp(vv, F.out[O_VP + (size_t)row * AW + 64 * h + lane], lane, 64);
            float fl = diag_proj(F, xr, FLC, lane, 16) * r; fl = (lane < 16) ? logsigmoidf_(fl + F.b_f[lane & 15]) : 0.f; bad[2] |= diag_cmp(fl, (lane < 16) ? F.out[O_LFP + (size_t)row * NH + lane] : 0.f, lane, 16);
            const int b = ri, j = 3 + 4 * hi, prow = b * SEQ + (SEQ - PBUF) + j; const float* xq = F.xp + (size_t)prow * DMODEL; const float r2 = diag_rinv(xq, lane);
            const float uu = diag_proj(F, xq, 64 * h, lane, 64) * r2; bad[3] |= diag_cmp(uu, F.out[O_PP + ((size_t)b * PBUF + j) * PW + 64 * h + lane], lane, 64); }
        { const int sr = srows[ri]; const float* xr = F.xs + (size_t)sr * DMODEL; const float r = diag_rinv(xr, lane);
            float kq = diag_proj(F, xr, 3072 + 64 * h, lane, 64) * r; float ss = wave_sum(kq * kq); kq = kq / sqrtf(ss * (1.0f / 64.0f) + EPS) * F.kg[lane];
            bad[4] |= diag_cmp(kq, F.out[O_KS + (size_t)sr * AW + 64 * h + lane], lane, 64);
            const float vv = diag_proj(F, xr, 4096 + 64 * h, lane, 64) * r; bad[5] |= diag_cmp(vv, F.out[O_VS + (size_t)sr * AW + 64 * h + lane], lane, 64);
            float fl = diag_proj(F, xr, FLC, lane, 16) * r; fl = (lane < 16) ? logsigmoidf_(fl + F.b_f[lane & 15]) : 0.f; bad[6] |= diag_cmp(fl, (lane < 16) ? F.out[O_LFS + (size_t)sr * NH + lane] : 0.f, lane, 16);
            const int b = sr >> 3, i = sr & 7; const float uu = diag_proj(F, xr, 64 * h, lane, 64) * r; bad[4] |= diag_cmp(uu, F.out[O_PS + ((size_t)b * PBUF + 7 + i) * PW + 64 * h + lane], lane, 64);
            const int r7 = hi * 3; bad[7] |= diag_cmp(F.state_pool[((size_t)b * PBUF + 8 + r7) * PW + 64 * h + lane], F.out[O_PS + ((size_t)b * PBUF + r7) * PW + 64 * h + lane], lane, 64); } }
    LAS unsigned* acc = (LAS unsigned*)(F.lds + 1024);
    if (tid_ == 0) *acc = 0u;
    __syncthreads();
    unsigned m = (bad[0] ? 1u : 0u) | (bad[1] ? 2u : 0u) | (bad[2] ? 4u : 0u) | (bad[3] ? 8u : 0u) | ((bad[4] || bad[5]) ? 16u : 0u) | ((bad[6] || bad[7]) ? 32u : 0u);
    if (lane == 0) atomicOr((unsigned*)acc, m);
    __syncthreads();
    if (tid_ == 0) F.out[O_YP] = 1.0e4f * (float)(1u + *acc);
}
#endif
#ifndef REP0
#define REP0 1
#define REP1 1
#define REP2 1
#define REP3 1
#define REP4 1
#define REP5 1
#define REP6 1
#endif
#ifndef SREP4
#define SREP4 1
#endif
#ifndef SREP5
#define SREP5 1
#endif
#ifndef SREP2
#define SREP2 1
#endif
#ifndef SREP3
#define SREP3 1
#endif
#ifndef SREP
#define SREP 1
#endif

__device__ __forceinline__ void phase_p1(Frame& F, const int bx, unsigned char* lds) {
    const bool qcu = (bx >= 32 && bx < 48), fused = (F.G == 256);
    for (int r_ = 0; r_ < SREP4; ++r_) if (fused || (F.G > LATE_CU0 && bx >= LATE_CU0)) p0_late_items(F, bx);
    if (!fused) { for (int su = bx; su < NIN / 64; su += F.G) sample_in_unit(F, su);
        if (qcu) q_publish(F); }
    const int ksplit = ((bx >> 3) & 3) + 1;
    EpiIn E{((float*)(F.ws + WS_RINV)), ((bf16*)(F.ws + WS_U)), ((bf16*)(F.ws + WS_GP)), ((bf16*)(F.ws + WS_Q)), ((bf16*)(F.ws + WS_KB)), ((bf16*)(F.ws + WS_VB)), ((bf16*)(F.ws + WS_GA)), (unsigned char*)(F.ws + WS_MA8), (unsigned char*)(F.ws + WS_MB8), F.out + O_KP, F.out + O_VP, F.out + O_PP, F.qg, F.kg};
    const pg8::Gemm g{DMODEL, DMODEL, DMODEL};
    { SchedIn S{F.G, bx, 0, ksplit, (const char*)((bf16*)(F.ws + WS_XB)), (const char*)((bf16*)(F.ws + WS_WIN))};
      pg8::gemm_phase<EpiIn, SchedIn, true, true>(F.lds + RING_OFF, g, S, E); }
    __syncthreads();
    if (!fused) q_wait(F);
    decode_partials(F); __syncthreads();
    if (REP2 == 2) { decode_partials(F); __syncthreads(); }
    if (REP2 == 3) { decode_partials<true>(F); __syncthreads(); }
    { SchedIn S{F.G, bx, ksplit, 5, (const char*)((bf16*)(F.ws + WS_XB)), (const char*)((bf16*)(F.ws + WS_WIN))};
      pg8::gemm_phase<EpiIn, SchedIn, true, true>(F.lds + RING_OFF, g, S, E); }
    __syncthreads();
}
__device__ __forceinline__ void phase_p2b(Frame& F, const int bx, unsigned char* lds) {
        const attn_body::AttnTensors AT{(const attn_body::bf16*)((bf16*)(F.ws + WS_Q)), (const attn_body::bf16*)((bf16*)(F.ws + WS_KB)), (const attn_body::bf16*)((bf16*)(F.ws + WS_VB)), (const attn_body::bf16*)((bf16*)(F.ws + WS_GA)), (attn_body::bf16*)(((bf16*)(F.ws + WS_AB)) + 1024), F.out + O_LFP};
        for (int r_ = 0; r_ < SREP2; ++r_) if ((bx & 7) >= 4 && bx < 32) sample_pool_unit(F, (bx >> 3) * 4 + (bx & 3));
        for (int r_ = 0; r_ < SREP3; ++r_) { const int job = F.vcu * NWAVES + F.wave; if (job < DB * NH * DS) decode_combine(F, job); }
        __syncthreads();
        const attn_body::StaticOrder S((int)F.G, bx);
#ifndef NO_ATT
        attn_body::attn_phase<attn_body::StaticOrder>((char*)lds + RING_OFF, AT, S);
#endif
        if (REP3 > 1) { __syncthreads(); attn_body::attn_phase<attn_body::StaticOrder>((char*)lds + RING_OFF, AT, S); }
        __syncthreads();
        for (int unit = bx; unit < 256; unit += F.G) pool_unit_lds(F, unit);
}
__device__ __forceinline__ void phase_p3(Frame& F, const int bx, unsigned char* lds) {
        pg8::Gemm g{DMODEL, DMODEL, DMODEL}; SchedUp S{F.G, bx, (const char*)((bf16*)(F.ws + WS_AB)), (const char*)((bf16*)(F.ws + WS_WUP))};
        EpiUp E{(const unsigned char*)(F.ws + WS_MA8), (const unsigned char*)(F.ws + WS_MB8), ((bf16*)(F.ws + WS_MG))};
        for (int r_ = 0; r_ < SREP; ++r_) for (int j = bx; j < 256; j += F.G) sample_up_sub(F, j);
        pg8::gemm_phase<EpiUp, SchedUp, true, true>(F.lds + RING_OFF, g, S, E);
}
__device__ __forceinline__ void phase_p4(Frame& F, const int bx, unsigned char* lds) {
        pg8::Gemm g{DMODEL, DMODEL, DMODEL}; SchedOut S{F.G, bx, (const char*)((bf16*)(F.ws + WS_MG)), (const char*)((bf16*)(F.ws + WS_WOUT))};
        EpiOut E{F.xp, F.out + O_YP};
        for (int r_ = 0; r_ < SREP; ++r_) for (int j = bx; j < 256; j += F.G) sample_out_sub(F, j);
        pg8::gemm_phase<EpiOut, SchedOut, true, true>(F.lds + RING_OFF, g, S, E);
}

__global__ void __launch_bounds__(NWAVES * 64, 2) mega_fwd(Args args) {
    extern __shared__ __attribute__((aligned(16))) unsigned char lds[];
    Frame F;
    F.lds = (LAS unsigned char*)lds;
    F.MISC = (volatile LAS unsigned*)(F.lds + MISC_OFF);
    F.wave = __builtin_amdgcn_readfirstlane((int)threadIdx.x >> 6);
    F.G = gridDim.x; { const int bx = blockIdx.x; F.vcu = (F.G % 8 == 0) ? (bx % 8) * (F.G / 8) + bx / 8 : bx; }
    unsigned char* ws = args.ws;
    F.ctl = (gu32*)(ws + WS_CTL);
    F.xp = args.in[0]; F.xs = args.in[1]; F.cache_k = args.in[2]; F.cache_v = args.in[3]; F.cache_lf = args.in[4]; F.state_pool = args.in[5]; F.page_table = (const int*)args.in[6];
    F.norm_gain = args.in[7]; F.w_in = args.in[8]; F.b_f = args.in[9]; F.qg = args.in[10]; F.kg = args.in[11]; F.w_pm = args.in[12]; F.pool_scale = args.in[13];
    F.w_upp = args.in[14]; F.w_upa = args.in[15]; F.w_out = args.in[16]; F.out = args.out;
    F.ws = ws;
    for (int u = threadIdx.x; u < (LDS_BYTES - LDSCTL_OFF) / 4; u += NWAVES * 64) ((LAS unsigned*)(F.lds + LDSCTL_OFF))[u] = 0u;
    __syncthreads();
    XcdBarrier bar = xcd_barrier_post((unsigned*)(F.ctl + CW_BAR), F.MISC + 8);
    const int bx = (int)blockIdx.x;
    p0_prologue(F); xcd_barrier(bar);
    if (REP0 > 1) { p0_prologue(F); xcd_barrier(bar); }
    phase_p1(F, bx, lds); xcd_barrier(bar);
    if (REP1 > 1) { phase_p1(F, bx, lds); xcd_barrier(bar); }
    phase_p2b(F, bx, lds); xcd_barrier(bar);
    if (REP4 > 1) { phase_p2b(F, bx, lds); xcd_barrier(bar); }
    phase_p3(F, bx, lds); xcd_barrier(bar);
    if (REP5 > 1) { phase_p3(F, bx, lds); xcd_barrier(bar); }
    if (REP6 > 1) { phase_p4(F, bx, lds); xcd_barrier(bar); }
    phase_p4(F, bx, lds);
#ifdef DIAG
    xcd_barrier(bar);
    diag_phase(F);
#endif
}

extern "C" void kernel_launch(void* const* d_in, const int* in_sizes, int n_in, void* d_out, int out_size, void* d_ws, size_t ws_size, hipStream_t stream) {
    static int grid = 0;
    if (grid == 0) {
        if (n_in != 17 || (size_t)out_size != O_END || ws_size < WS_END) { fprintf(stderr, "kernel_launch: unexpected shapes (n_in %d, out %d, ws %zu); nothing launched\n", n_in, out_size, ws_size); grid = -1; return; }
        int dev = 0, cus = 0, per_cu = 0;
        if (hipGetDevice(&dev) != hipSuccess || hipDeviceGetAttribute(&cus, hipDeviceAttributeMultiprocessorCount, dev) != hipSuccess) { grid = -1; return; }
        if (hipFuncSetAttribute((const void*)mega_fwd, hipFuncAttributeMaxDynamicSharedMemorySize, LDS_BYTES) != hipSuccess) { fprintf(stderr, "kernel_launch: hipFuncSetAttribute failed\n"); grid = -1; return; }
        if (hipOccupancyMaxActiveBlocksPerMultiprocessor(&per_cu, (const void*)mega_fwd, NWAVES * 64, LDS_BYTES) != hipSuccess || per_cu < 1) fprintf(stderr, "kernel_launch: occupancy query reports %d\n", per_cu);
        (void)hipGetLastError();
        grid = cus;
        if (grid != 256) fprintf(stderr, "kernel_launch: %d CUs; the work split assumes 256\n", grid);
    }
    if (grid < 0) return;
    if (hipMemsetAsync((char*)d_ws + WS_CTL, 0, CTL_ZERO_BYTES, stream) != hipSuccess) return;
    Args a{};
    for (int i = 0; i < 17; ++i) a.in[i] = (const float*)d_in[i];
    a.out = (float*)d_out; a.ws = (unsigned char*)d_ws;
    hipLaunchKernelGGL(mega_fwd, dim3(grid), dim3(NWAVES * 64), LDS_BYTES, stream, a);
}
```

```cpp
#include <hip/hip_runtime.h>
#include <hip/hip_bf16.h>
#include <cstdio>
#include <cstdint>
#include <cmath>

__device__ __forceinline__ int tid_fresh() { int t = threadIdx.x; asm volatile("" : "+v"(t)); return t; }
namespace pg8 {
#define PG8_LAS __attribute__((address_space(3)))
typedef unsigned short bf16_t;
typedef short bf16x8 __attribute__((ext_vector_type(8)));
typedef float f32x4 __attribute__((ext_vector_type(4)));
typedef unsigned u32x4 __attribute__((ext_vector_type(4)));
constexpr int BM = 256, BK = 64, HALF = 128, HTB = HALF * BK * 2  , STAGE_BYTES = 8 * HTB, NXCD = 8, WGM = 8;

__host__ __device__ __forceinline__ int lds_byte(int r, int c) { const int st = (r >> 4) * 2 + (c >> 5), rr = r & 15, cc = c & 31, ob = rr * 64 + cc * 2; return st * 1024 + (ob ^ (((ob >> 9) & 1) << 5)); }
__host__ __device__ __forceinline__ void stage_rc(int b, int& R, int& C) { const int st = b / 1024, sb = b % 1024, swz = sb ^ (((sb >> 9) & 1) << 5); R = (st >> 1) * 16 + swz / 64; C = (st & 1) * 32 + (swz % 64) / 2; }
__host__ __device__ __forceinline__ int perm32(int rho) { const int n = rho >> 4, i = rho & 15; return 8 * (i >> 2) + 4 * n + (i & 3); }

struct Unit { int pm, pn, aux; const char* a; const char* b; };
struct Gemm { int lda, ldb, K; };

__device__ __forceinline__ bool static_tile(int i, int G, int c, int nM, int nN, int& pm, int& pn) {
    const int nwg = nM * nN; const long L = (long)i * G + c; if (L >= nwg) return false;
    int wgid = (int)L; { const int q = nwg / NXCD, r = nwg % NXCD, xcd = wgid % NXCD, off = wgid / NXCD; wgid = (xcd < r ? xcd * (q + 1) : r * (q + 1) + (xcd - r) * q) + off; }
    const int nig = WGM * nN, gid = wgid / nig, fm = gid * WGM, gsz = (nM - fm) < WGM ? (nM - fm) : WGM;
    pm = fm + ((wgid % nig) % gsz); pn = (wgid % nig) / gsz; return true;
}
__device__ __forceinline__ unsigned cvt_pk_bf16(float lo, float hi) { unsigned r; asm volatile("s_nop 0\n\tv_cvt_pk_bf16_f32 %0, %1, %2" : "=v"(r) : "v"(lo), "v"(hi)); return r; }

#ifndef EPI_TWICE
#define EPI_TWICE 0
#endif
template <class Epi, class Sched, bool ALIGN_EPI = false, bool SP2 = false>
__device__ __forceinline__ void gemm_phase(PG8_LAS unsigned char* lds, const Gemm g, const Sched& S, const Epi& E) {
    const int tid = tid_fresh(), wid = __builtin_amdgcn_readfirstlane(tid >> 6), lane = tid & 63, wr = wid >> 2, wc = wid & 3, fr = lane & 15, fq = lane >> 4;
    const int K = g.K, nt = K / BK;
    unsigned voffA[2], voffB[2];
#pragma unroll
    for (int i = 0; i < 2; ++i) { int R, C; stage_rc(tid * 16 + i * 8192, R, C); const int Rb = Epi::PERM ? ((R & ~31) + perm32(R & 31)) : R;
        voffA[i] = (unsigned)(R * g.lda + C) * 2u; voffB[i] = (unsigned)(Rb * g.ldb + C) * 2u; }
    const size_t kstep = (size_t)(BK * 2);
    const size_t hA = (size_t)HALF * g.lda * 2, hB = (size_t)HALF * g.ldb * 2;
    const unsigned ldsw = (unsigned)wid * 1024u;
    const int aoff = lds_byte(wr * 64 + fr, fq * 8), boff = lds_byte(wc * 32 + fr, fq * 8);
#define PG8_SA(b, h) (((b) * 2 + (h)) * HTB)
#define PG8_SB(b, h) ((4 + (b) * 2 + (h)) * HTB)
#define PG8_STAGE(bufoff, gbase, voff) do { _Pragma("unroll") for (int _i = 0; _i < 2; ++_i) \
        __builtin_amdgcn_global_load_lds((const unsigned*)((const char*)(gbase) + (voff)[_i]), (PG8_LAS unsigned*)(lds + (bufoff) + ldsw + _i * 8192), 16, 0, 0); } while (0)
#define PG8_LDA(dst, b, h) do { _Pragma("unroll") for (int m = 0; m < 4; ++m) _Pragma("unroll") for (int k = 0; k < 2; ++k) dst[m][k] = *(const PG8_LAS bf16x8*)(lds + PG8_SA(b, h) + aoff + m * 2048 + k * 1024); } while (0)
#define PG8_LDB(dst, b, h) do { _Pragma("unroll") for (int n = 0; n < 2; ++n) _Pragma("unroll") for (int k = 0; k < 2; ++k) dst[n][k] = *(const PG8_LAS bf16x8*)(lds + PG8_SB(b, h) + boff + n * 2048 + k * 1024); } while (0)
#define PG8_MMA(ai, bj, At, Bt) do { __builtin_amdgcn_s_setprio(1); _Pragma("unroll") for (int m = 0; m < 4; ++m) _Pragma("unroll") for (int n = 0; n < 2; ++n) _Pragma("unroll") for (int k = 0; k < 2; ++k) \
        acc[ai][bj][m][n] = __builtin_amdgcn_mfma_f32_16x16x32_bf16(Bt[n][k], At[m][k], acc[ai][bj][m][n], 0, 0, 0); __builtin_amdgcn_s_setprio(0); } while (0)
#define PG8_WAIT_V(n) asm volatile("s_waitcnt vmcnt(" #n ")" ::: "memory")
#define PG8_WAIT_L(n) asm volatile("s_waitcnt lgkmcnt(" #n ")" ::: "memory")
#define PG8_BAR __builtin_amdgcn_s_barrier()
#define PG8_PF(it) do { if constexpr (Epi::HAS_PF) __builtin_amdgcn_global_load_lds((const unsigned*)E.pf((it), cur, wid, lane), (PG8_LAS unsigned*)(lds + 131072 + wid * 256), 4, 0, 0); } while (0)
#define PG8_WAIT_VP() do { if constexpr (Epi::HAS_PF) PG8_WAIT_V(9); else PG8_WAIT_V(8); } while (0)
#define PG8_SCHED __builtin_amdgcn_sched_barrier(0)
    Unit cur, nxt; int ui = 0;
    if (!S.next(0, cur)) return;
    f32x4 acc[2][2][4][2];
#pragma unroll
    for (int a = 0; a < 2; ++a)
#pragma unroll
        for (int b = 0; b < 2; ++b)
#pragma unroll
            for (int m = 0; m < 4; ++m)
#pragma unroll
                for (int n = 0; n < 2; ++n) acc[a][b][m][n] = (f32x4){0.f, 0.f, 0.f, 0.f};
    bf16x8 At[4][2], B0[2][2], B1[2][2];
    const char* cA = cur.a; const char* cB = cur.b;
    S.a_ready(cur);
    if constexpr (SP2) {
        PG8_STAGE(PG8_SB(0, 0), cB, voffB); PG8_STAGE(PG8_SB(0, 1), cB + hB, voffB); PG8_STAGE(PG8_SA(0, 0), cA, voffA); PG8_STAGE(PG8_SA(0, 1), cA + hA, voffA);
        if (wr == 1) PG8_BAR;
        PG8_WAIT_V(2); PG8_BAR;
        PG8_STAGE(PG8_SB(1, 0), cB + kstep, voffB); PG8_STAGE(PG8_SA(1, 0), cA + kstep, voffA); PG8_STAGE(PG8_SB(1, 1), cB + hB + kstep, voffB);
        PG8_WAIT_V(6); PG8_BAR;
    } else {
        PG8_STAGE(PG8_SB(0, 0), cB, voffB); PG8_STAGE(PG8_SA(0, 0), cA, voffA); PG8_STAGE(PG8_SB(0, 1), cB + hB, voffB); PG8_STAGE(PG8_SA(0, 1), cA + hA, voffA);
        if (wr == 1) PG8_BAR;
        PG8_WAIT_V(4); PG8_BAR;
        PG8_STAGE(PG8_SB(1, 0), cB + kstep, voffB); PG8_STAGE(PG8_SA(1, 0), cA + kstep, voffA); PG8_STAGE(PG8_SB(1, 1), cB + hB + kstep, voffB);
        PG8_WAIT_V(6); PG8_BAR;
    }
    for (;;) {
        const bool has_next = S.next(ui + 1, nxt);
        const char* nA = has_next ? nxt.a : cA; const char* nB = has_next ? nxt.b : cB;
        for (int t = 0; t < nt; t += 2) {
            if constexpr (Epi::HAS_MID) { if (t == nt / 2) E.mid(acc, cur, wr, wc); }
            const bool last = (t == nt - 2);
            const char* a1 = cA + (size_t)(t + 1) * kstep;
            const char* a2 = last ? nA : cA + (size_t)(t + 2) * kstep; const char* b2 = last ? nB : cB + (size_t)(t + 2) * kstep;
            const char* a3 = a2 + kstep; const char* b3 = b2 + kstep;
            if (last && has_next) S.a_ready(nxt);
            if constexpr (SP2) {
            PG8_LDB(B0, 0, 0); PG8_LDB(B1, 0, 1); PG8_SCHED; PG8_LDA(At, 0, 0); PG8_STAGE(PG8_SA(1, 1), a1 + hA, voffA); PG8_PF(t >> 1);
            PG8_WAIT_VP(); PG8_WAIT_L(0); PG8_BAR; PG8_MMA(0, 0, At, B0); PG8_MMA(0, 1, At, B1); PG8_BAR; PG8_SCHED;
            PG8_LDA(At, 0, 1); PG8_STAGE(PG8_SB(0, 0), b2, voffB); PG8_STAGE(PG8_SB(0, 1), b2 + hB, voffB); PG8_STAGE(PG8_SA(0, 0), a2, voffA);
            PG8_WAIT_VP(); PG8_WAIT_L(0); PG8_BAR; PG8_MMA(1, 0, At, B0); PG8_MMA(1, 1, At, B1); PG8_BAR; PG8_SCHED;
            PG8_LDB(B0, 1, 0); PG8_LDB(B1, 1, 1); PG8_SCHED; PG8_LDA(At, 1, 0); PG8_STAGE(PG8_SA(0, 1), a2 + hA, voffA);
            PG8_WAIT_VP(); PG8_WAIT_L(0); PG8_BAR; PG8_MMA(0, 0, At, B0); PG8_MMA(0, 1, At, B1); PG8_BAR; PG8_SCHED;
            PG8_LDA(At, 1, 1); PG8_STAGE(PG8_SB(1, 0), b3, voffB); PG8_STAGE(PG8_SB(1, 1), b3 + hB, voffB); PG8_STAGE(PG8_SA(1, 0), a3, voffA);
            PG8_WAIT_V(8); PG8_WAIT_L(0); PG8_BAR; PG8_MMA(1, 0, At, B0); PG8_MMA(1, 1, At, B1); PG8_BAR; PG8_SCHED;
            } else {
            static_assert(!Epi::HAS_PF, "the prefetch slot exists in the SP2 schedule only");
            PG8_LDB(B0, 0, 0); PG8_SCHED; PG8_LDA(At, 0, 0); PG8_STAGE(PG8_SA(1, 1), a1 + hA, voffA);
            PG8_WAIT_L(8); PG8_BAR; PG8_WAIT_L(0); PG8_MMA(0, 0, At, B0); PG8_BAR; PG8_SCHED;
            PG8_LDB(B1, 0, 1); PG8_STAGE(PG8_SB(0, 0), b2, voffB);
            PG8_BAR; PG8_WAIT_L(0); PG8_MMA(0, 1, At, B1); PG8_BAR;
            PG8_LDA(At, 0, 1); PG8_STAGE(PG8_SA(0, 0), a2, voffA);
            PG8_BAR; PG8_WAIT_L(0); PG8_MMA(1, 0, At, B0); PG8_BAR; PG8_SCHED;
            PG8_STAGE(PG8_SB(0, 1), b2 + hB, voffB);
            PG8_WAIT_V(6); PG8_BAR; PG8_MMA(1, 1, At, B1); PG8_BAR;
            PG8_LDB(B0, 1, 0); PG8_SCHED; PG8_LDA(At, 1, 0); PG8_STAGE(PG8_SA(0, 1), a2 + hA, voffA);
            PG8_WAIT_L(8); PG8_BAR; PG8_WAIT_L(0); PG8_MMA(0, 0, At, B0); PG8_BAR; PG8_SCHED;
            PG8_LDB(B1, 1, 1); PG8_STAGE(PG8_SB(1, 0), b3, voffB);
            PG8_BAR; PG8_WAIT_L(0); PG8_MMA(0, 1, At, B1); PG8_BAR;
            PG8_LDA(At, 1, 1); PG8_STAGE(PG8_SA(1, 0), a3, voffA);
            PG8_BAR; PG8_WAIT_L(0); PG8_MMA(1, 0, At, B0); PG8_BAR; PG8_SCHED;
            PG8_STAGE(PG8_SB(1, 1), b3 + hB, voffB);
            PG8_WAIT_V(6); PG8_BAR; PG8_MMA(1, 1, At, B1); PG8_BAR;
            }
        }
        if constexpr (ALIGN_EPI) { if (wr == 0) PG8_BAR; }
        if constexpr (!Epi::AFTER_DRAIN) { E(acc, cur, wr, wc, fr, fq);
            if constexpr ((EPI_TWICE & Epi::ID) != 0) E(acc, cur, wr, wc, fr, fq);
            S.done(cur); }
        else if (has_next) { E(acc, cur, wr, wc, fr, fq); S.done(cur); }
        if (!has_next) break;
#pragma unroll
        for (int a = 0; a < 2; ++a)
#pragma unroll
            for (int b = 0; b < 2; ++b)
#pragma unroll
                for (int m = 0; m < 4; ++m)
#pragma unroll
                    for (int n = 0; n < 2; ++n) acc[a][b][m][n] = (f32x4){0.f, 0.f, 0.f, 0.f};
        cur = nxt; cA = nA; cB = nB; ++ui;
        if constexpr (ALIGN_EPI) { if (wr == 1) PG8_BAR; }
    }
    PG8_WAIT_V(0);
    if constexpr (!ALIGN_EPI) { if (wr == 0) PG8_BAR; }
    PG8_BAR;
    if constexpr (Epi::AFTER_DRAIN) { E.fused(acc, cur, wr, wc, fr, fq, lds, wid, lane);
        if constexpr ((EPI_TWICE & Epi::ID) != 0) E.fused(acc, cur, wr, wc, fr, fq, lds, wid, lane);
        S.done(cur); }
#undef PG8_SA
#undef PG8_SB
#undef PG8_STAGE
#undef PG8_LDA
#undef PG8_LDB
#undef PG8_MMA
#undef PG8_WAIT_V
#undef PG8_WAIT_L
#undef PG8_BAR
#undef PG8_PF
#undef PG8_WAIT_VP
#undef PG8_SCHED
}
}

#include <hip/hip_bf16.h>
#include <cmath>
namespace attn_body {
using bf16=__hip_bfloat16;
using bf16x8=__attribute__((ext_vector_type(8)))short;
using s16x4=__attribute__((ext_vector_type(4)))short;
using f32x16=__attribute__((ext_vector_type(16)))float;
using u32x4=__attribute__((ext_vector_type(4)))unsigned;
constexpr int BATCH=4,NHEAD=16,SEQ=2048,D=64,DM=NHEAD*D,OPITCH=2048;
constexpr int NW=8,QBLK=32,QB=QBLK*NW,KVBLK=64,NQB=SEQ/QB;
constexpr int ATTN_PITCH=DM, ATTN_UNIT_ROWS=QB;
__device__ __forceinline__ int crow(int r,int hi){return (r&3)+8*(r>>2)+4*hi;}
#define SBAR() __builtin_amdgcn_sched_barrier(0)
__device__ __forceinline__ void cmask(f32x16&p0,f32x16&p1,int jb,int qrel,int hi){
  const float NEG=-INFINITY; int kb=64*jb+4*hi;
  #pragma unroll
  for(int r=0;r<16;++r){int kv=kb+(r&3)+8*(r>>2); if(kv>qrel)p0[r]=NEG; if(kv+32>qrel)p1[r]=NEG;}
}

constexpr int NSLOT=3, SLOTB=8192;
constexpr int LDS_K=0, LDS_V=NSLOT*SLOTB, LDS_WS=2*NSLOT*SLOTB, LDS_OST=LDS_WS+NW*64*4, LDS_FS2=LDS_OST+NW*4096, LDS_BYTES=LDS_FS2+SEQ*4;
constexpr float C2=0.125f*1.4426950408889634f;
__device__ __forceinline__ void glds16(const void*gsrc,unsigned lds_dst){unsigned keep;
  asm volatile("s_mov_b32 %0, m0\n\ts_mov_b32 m0, %2\n\ts_nop 0\n\tglobal_load_lds_dwordx4 %1, off\n\ts_mov_b32 m0, %0":"=&s"(keep):"v"(gsrc),"s"(lds_dst):"memory");}
__device__ __forceinline__ float max3f(float a,float b,float c){float r;asm("v_max3_f32 %0, %1, %2, %3":"=v"(r):"v"(a),"v"(b),"v"(c));return r;}
__device__ __forceinline__ float max2f(float a,float b){float r;asm("v_max_f32_e32 %0, %1, %2":"=v"(r):"v"(a),"v"(b));return r;}
__device__ __forceinline__ float fadd_s(float a,float b){float r;asm("v_add_f32_e32 %0, %1, %2":"=v"(r):"v"(a),"v"(b));return r;}
__device__ __forceinline__ float fsub_s(float a,float b){float r;asm("v_sub_f32_e32 %0, %1, %2":"=v"(r):"v"(a),"v"(b));return r;}
typedef float f32x2_t __attribute__((ext_vector_type(2))); typedef __bf16 bf16x2_t __attribute__((ext_vector_type(2)));
__device__ __forceinline__ unsigned cvtpk_s(float lo,float hi){f32x2_t v={lo,hi};bf16x2_t b=__builtin_convertvector(v,bf16x2_t);return __builtin_bit_cast(unsigned,b);}
#define WAIT_BAR(N) asm volatile("s_waitcnt vmcnt(" #N ") lgkmcnt(0)\n\ts_barrier":::"memory")

__device__ __forceinline__ void qkt(f32x16&p0,f32x16&p1,const char*Kslot,const bf16x8*qr,int r32,int hi){
  const char*kb=Kslot+hi*1024+r32*16;
  #pragma unroll
  for(int d0=0;d0<4;++d0){
    const bf16x8 b0=*reinterpret_cast<const bf16x8*>(kb+d0*2048);
    const bf16x8 b1=*reinterpret_cast<const bf16x8*>(kb+d0*2048+512);
    {p0=__builtin_amdgcn_mfma_f32_32x32x16_bf16(b0,qr[d0],p0,0,0,0);p1=__builtin_amdgcn_mfma_f32_32x32x16_bf16(b1,qr[d0],p1,0,0,0);}}
}
typedef __attribute__((address_space(3))) const char* lds_cptr;
typedef short v4i16_t __attribute__((ext_vector_type(4)));
__device__ __forceinline__ void kload8(bf16x8*kf,lds_cptr kp){
  kf[0]=*(const __attribute__((address_space(3))) bf16x8*)(kp);      kf[1]=*(const __attribute__((address_space(3))) bf16x8*)(kp+512);
  kf[2]=*(const __attribute__((address_space(3))) bf16x8*)(kp+2048); kf[3]=*(const __attribute__((address_space(3))) bf16x8*)(kp+2560);
  kf[4]=*(const __attribute__((address_space(3))) bf16x8*)(kp+4096); kf[5]=*(const __attribute__((address_space(3))) bf16x8*)(kp+4608);
  kf[6]=*(const __attribute__((address_space(3))) bf16x8*)(kp+6144); kf[7]=*(const __attribute__((address_space(3))) bf16x8*)(kp+6656);
}
__device__ __forceinline__ void kload2(bf16x8*kf,lds_cptr kp,int j){ kf[2*j]=*(const __attribute__((address_space(3))) bf16x8*)(kp+j*2048); kf[2*j+1]=*(const __attribute__((address_space(3))) bf16x8*)(kp+j*2048+512); }
__device__ __forceinline__ s16x4 vtr(lds_cptr p){ return __builtin_bit_cast(s16x4,__builtin_amdgcn_ds_read_tr16_b64_v4i16((__attribute__((address_space(3))) v4i16_t*)p)); }
__device__ __forceinline__ float rowmax(const f32x16&p0,const f32x16&p1){
  float a=max3f(p0[0],p0[1],p1[0]),b=max3f(p0[2],p0[3],p1[1]);a=max3f(a,p1[2],p1[3]);
  #pragma unroll
  for(int r=4;r<16;r+=4){a=max3f(a,p0[r],p0[r+1]);b=max3f(b,p0[r+2],p0[r+3]);a=max3f(a,p1[r],p1[r+1]);b=max3f(b,p1[r+2],p1[r+3]);}
  const float m=max2f(a,b);
  auto rr=__builtin_amdgcn_permlane32_swap(__float_as_uint(m),__float_as_uint(m),false,false);
  return max2f(__uint_as_float(rr[0]),__uint_as_float(rr[1]));
}
__device__ __forceinline__ void pv(f32x16*o,int vb,bf16x8 pa0,bf16x8 pa1,bf16x8 pa2,bf16x8 pa3){
  #pragma unroll
  for(int d0=0;d0<2;++d0){s16x4 lo[4],hi[4];
    #pragma unroll
    for(int ks=0;ks<4;++ks){
      asm volatile("ds_read_b64_tr_b16 %0,%1 offset:%c2":"=&v"(lo[ks]):"v"(vb),"i"(d0*4096+ks*1024):"memory");
      asm volatile("ds_read_b64_tr_b16 %0,%1 offset:%c2":"=&v"(hi[ks]):"v"(vb),"i"(d0*4096+ks*1024+512):"memory");}
    asm volatile("s_waitcnt lgkmcnt(0)":::"memory");SBAR();
    #define PK(k) (bf16x8){lo[k][0],lo[k][1],lo[k][2],lo[k][3],hi[k][0],hi[k][1],hi[k][2],hi[k][3]}
    o[d0]=__builtin_amdgcn_mfma_f32_32x32x16_bf16(pa0,PK(0),o[d0],0,0,0);
    o[d0]=__builtin_amdgcn_mfma_f32_32x32x16_bf16(pa1,PK(1),o[d0],0,0,0);
    o[d0]=__builtin_amdgcn_mfma_f32_32x32x16_bf16(pa2,PK(2),o[d0],0,0,0);
    o[d0]=__builtin_amdgcn_mfma_f32_32x32x16_bf16(pa3,PK(3),o[d0],0,0,0);
    #undef PK
  }
}

#ifndef ATTN_STORE16
#define ATTN_STORE16(p,v) (*(u32x4*)(p)=(v))
#endif
template<int THRL> __device__ __forceinline__ void attn_unit(int b,int h,int qb,const bf16*Q,const bf16*__restrict__ K,const bf16*__restrict__ V,const bf16*__restrict__ G,bf16*O,char*shm){
  const int tid=tid_fresh(),lane=tid&63,r32=lane&31,hi=lane>>5; const int wid=__builtin_amdgcn_readfirstlane(tid>>6);
  const long rowbase=(long)b*SEQ; const int q0=qb*QB;
  const bf16*Qw=Q+(rowbase+q0+wid*QBLK)*DM+h*D;
  const bf16*Kh=K+rowbase*DM+h*D,*Vh=V+rowbase*DM+h*D;
  const unsigned lds0=(unsigned)(uintptr_t)shm;
  float*wsf=(float*)(shm+LDS_WS)+wid*64;
  const bf16*ksrc=Kh+(long)lane*DM+wid*8;
  const bf16*vsrc=Vh+(long)(16*(wid&3)+(lane>>2))*DM+(wid>>2)*32+(lane&3)*8;
  const unsigned kdst=lds0+LDS_K+wid*1024, vdst=lds0+LDS_V+wid*1024;
  #define DMA_K(t,slot) glds16(ksrc+(long)(t)*KVBLK*DM,(unsigned)__builtin_amdgcn_readfirstlane(kdst+(slot)))
  #define DMA_V(t,slot) glds16(vsrc+(long)(t)*KVBLK*DM,(unsigned)__builtin_amdgcn_readfirstlane(vdst+(slot)))
  const int vb0=(int)(lds0+LDS_V)+((lane>>4)&1)*32+(lane&3)*8+(4*hi+((lane&15)>>2))*64;
  const char*Kbase=shm+LDS_K; bf16x8 kf[8];
  const lds_cptr shm3=(lds_cptr)shm; const lds_cptr kp0=shm3+LDS_K+hi*1024+r32*16; const lds_cptr vp0=shm3+LDS_V+((lane>>4)&1)*32+(lane&3)*8+(4*hi+((lane&15)>>2))*64;
  typedef float f32x4a __attribute__((ext_vector_type(4)));
  const __attribute__((address_space(3))) f32x4a* fsb=(const __attribute__((address_space(3))) f32x4a*)(shm3+LDS_FS2)+hi;
  #define BINIT(P,t,o32) do{ const __attribute__((address_space(3))) f32x4a* fb_=fsb+(t)*16+(o32)*8; \
    _Pragma("unroll") for(int rg_=0;rg_<4;++rg_){ const f32x4a b0_=fb_[2*rg_]; \
      P[4*rg_]=b0_[0]-mhat;P[4*rg_+1]=b0_[1]-mhat;P[4*rg_+2]=b0_[2]-mhat;P[4*rg_+3]=b0_[3]-mhat; } asm volatile("":"+v"(P)); SBAR(); }while(0)
  const int NT=(q0+QB)/KVBLK;
  DMA_K(0,0);DMA_V(0,0);DMA_K(1,SLOTB);
  bf16x8 qr[4];
  #pragma unroll
  for(int d0=0;d0<4;++d0)qr[d0]=*reinterpret_cast<const bf16x8*>(&Qw[(long)r32*DM+d0*16+hi*8]);
  float mhat=0.f,l_reg=0.f;f32x16 o[2];o[0]=f32x16{};o[1]=f32x16{};
  const int qrel=wid*QBLK+r32;
  #define CMASK(P0,P1,t) do{int jb_=(t)-(NT-4); if(jb_>=0)cmask(P0,P1,jb_,qrel,hi);}while(0)
  bool resc=false;
  #define START(P0,P1) do{ const float rm=rowmax(P0,P1); resc=false; \
    { const float dl=rm; mhat=fadd_s(mhat,dl); \
      _Pragma("unroll") for(int r=0;r<16;++r){P0[r]=fsub_s(P0[r],dl);P1[r]=fsub_s(P1[r],dl);} \
      } \
    _Pragma("unroll") for(int r=0;r<16;++r)P0[r]=__builtin_amdgcn_exp2f(P0[r]); }while(0)
  #define RESC() do{ if(resc){ asm volatile("s_waitcnt lgkmcnt(0)":::"memory"); \
      _Pragma("unroll") for(int d_=0;d_<2;++d_) _Pragma("unroll") for(int r=0;r<16;++r)o[d_][r]*=wsf[crow(r,hi)]; } }while(0)
  f32x16 pA0,pA1,pB0,pB1;
  int sl_prev=0,sl_cur=0,sl_next=SLOTB;
  #define ROT() do{sl_prev=sl_cur;sl_cur=sl_next;sl_next=(sl_next==(NSLOT-1)*SLOTB)?0:sl_next+SLOTB;}while(0)
  DMA_K(2,2*SLOTB);
  WAIT_BAR(3);
  BINIT(pA0,0,0);BINIT(pA1,0,1);qkt(pA0,pA1,Kbase,qr,r32,hi);asm volatile("s_nop 15\n\ts_nop 7":"+v"(pA0),"+v"(pA1));CMASK(pA0,pA1,0);
  START(pA0,pA1);
  _Pragma("unroll") for(int r=0;r<16;++r)pA1[r]=__builtin_amdgcn_exp2f(pA1[r]);
  WAIT_BAR(0);
  DMA_K(3,0);DMA_V(1,SLOTB);
  ROT();
  kload8(kf,kp0+sl_cur);
  WAIT_BAR(2);
  s16x4 vlo[8],vhi[8]; u32x4 pw0,pw1,pw2,pw3;
  #define PKW(P,B) cvtpk_s(P[B],P[B+1])
  #define PAF(k) __builtin_bit_cast(bf16x8,pw##k)
  #define VFR(i) (bf16x8){vlo[i][0],vlo[i][1],vlo[i][2],vlo[i][3],vhi[i][0],vhi[i][1],vhi[i][2],vhi[i][3]}
  #define PIN(x) asm volatile("":"+v"(x))
  #define MX3(a,b,c) __builtin_fmaxf(__builtin_fmaxf((a),(b)),(c))
  #define GAPA(MF,A0,A1,A2,A3,W0,W1,PW) do{ MF; sacc+=A0; sacc+=A1; sacc+=A2; sacc+=A3; PIN(sacc); W0; W1; PIN(PW); SBAR(); }while(0)
  #define EX(v) __builtin_amdgcn_exp2f(v)
  #define GAPB(MF,X,B) do{ MF; X[B]=EX(X[B]); X[B+1]=EX(X[B+1]); X[B+2]=EX(X[B+2]); X[B+3]=EX(X[B+3]); PIN(X); SBAR(); }while(0)
  #define VRD(i) do{ vlo[i]=vtr(vp_+(((i)>>2)*4096+((i)&3)*1024)); vhi[i]=vtr(vp_+(((i)>>2)*4096+((i)&3)*1024+512)); }while(0)
  #define KRD(G,j) do{ if(G){ kload2(kf,kp0+sl_next,j); SBAR(); } }while(0)
  #define STEP(C0,C1,P0,P1,t,GK,GV,GL) do{ SBAR(); \
    const lds_cptr vp_=vp0+sl_prev; \
    BINIT(C0,t,0); VRD(0); SBAR(); float sacc=(P0[0]+P0[1]); \
    GAPA(C0=__builtin_amdgcn_mfma_f32_32x32x16_bf16(kf[0],qr[0],C0,0,0,0), P0[2],P0[3],P0[4],P0[5],     pw0[0]=PKW(P0,0), pw0[1]=PKW(P0,2), pw0); \
    BINIT(C1,t,1); VRD(4); SBAR(); GAPA(C1=__builtin_amdgcn_mfma_f32_32x32x16_bf16(kf[1],qr[0],C1,0,0,0), P0[6],P0[7],P0[8],P0[9],     pw0[2]=PKW(P0,4), pw0[3]=PKW(P0,6), pw0); \
    VRD(1); SBAR(); GAPA(C0=__builtin_amdgcn_mfma_f32_32x32x16_bf16(kf[2],qr[1],C0,0,0,0),   P0[10],P0[11],P0[12],P0[13], pw1[0]=PKW(P0,8), pw1[1]=PKW(P0,10), pw1); \
    VRD(5); SBAR(); GAPA(C1=__builtin_amdgcn_mfma_f32_32x32x16_bf16(kf[3],qr[1],C1,0,0,0),   P0[14],P0[15],P1[0],P1[1],   pw1[2]=PKW(P0,12),pw1[3]=PKW(P0,14), pw1); \
    VRD(2); SBAR(); GAPA(C0=__builtin_amdgcn_mfma_f32_32x32x16_bf16(kf[4],qr[2],C0,0,0,0),   P1[2],P1[3],P1[4],P1[5],     pw2[0]=PKW(P1,0), pw2[1]=PKW(P1,2), pw2); \
    VRD(6); SBAR(); GAPA(C1=__builtin_amdgcn_mfma_f32_32x32x16_bf16(kf[5],qr[2],C1,0,0,0),   P1[6],P1[7],P1[8],P1[9],     pw2[2]=PKW(P1,4), pw2[3]=PKW(P1,6), pw2); \
    VRD(3); SBAR(); GAPA(C0=__builtin_amdgcn_mfma_f32_32x32x16_bf16(kf[6],qr[3],C0,0,0,0),   P1[10],P1[11],P1[12],P1[13], pw3[0]=PKW(P1,8), pw3[1]=PKW(P1,10), pw3); \
    VRD(7); SBAR(); GAPA(C1=__builtin_amdgcn_mfma_f32_32x32x16_bf16(kf[7],qr[3],C1,0,0,0),   P1[14],P1[15],0.f,0.f,       pw3[2]=PKW(P1,12),pw3[3]=PKW(P1,14), pw3); \
    l_reg+=sacc; \
    if(GK){DMA_K((t)+3,sl_cur);} if(GV){DMA_V((t)+1,sl_next);} \
    CMASK(C0,C1,t); \
    { float a=MX3(C0[0],C0[1],C1[0]),b=MX3(C0[2],C0[3],C1[1]); a=MX3(a,C1[2],C1[3]); \
      _Pragma("unroll") for(int r=4;r<16;r+=4){a=MX3(a,C0[r],C0[r+1]);b=MX3(b,C0[r+2],C0[r+3]);a=MX3(a,C1[r],C1[r+1]);b=MX3(b,C1[r+2],C1[r+3]);} \
      float rm=__builtin_fmaxf(a,b); { auto rr=__builtin_amdgcn_permlane32_swap(__float_as_uint(rm),__float_as_uint(rm),false,false); rm=__builtin_fmaxf(__uint_as_float(rr[0]),__uint_as_float(rr[1])); } \
      resc=false; \
      if(__builtin_expect(__any(rm>(float)THRL),0)){ const float dl=__builtin_fmaxf(rm,0.f); mhat+=dl; \
        _Pragma("unroll") for(int r=0;r<16;++r){C0[r]-=dl;C1[r]-=dl;} \
        const float f=__builtin_amdgcn_exp2f(-dl); l_reg*=f; if(hi==0)wsf[r32]=f; resc=true; } } \
    SBAR(); \
    GAPB(o[0]=__builtin_amdgcn_mfma_f32_32x32x16_bf16(PAF(0),VFR(0),o[0],0,0,0), C0,0); \
    GAPB(o[1]=__builtin_amdgcn_mfma_f32_32x32x16_bf16(PAF(0),VFR(4),o[1],0,0,0), C0,4); \
    KRD(GL,0); GAPB(o[0]=__builtin_amdgcn_mfma_f32_32x32x16_bf16(PAF(1),VFR(1),o[0],0,0,0), C0,8); \
    KRD(GL,1); GAPB(o[1]=__builtin_amdgcn_mfma_f32_32x32x16_bf16(PAF(1),VFR(5),o[1],0,0,0), C0,12); \
    KRD(GL,2); GAPB(o[0]=__builtin_amdgcn_mfma_f32_32x32x16_bf16(PAF(2),VFR(2),o[0],0,0,0), C1,0); \
    KRD(GL,3); GAPB(o[1]=__builtin_amdgcn_mfma_f32_32x32x16_bf16(PAF(2),VFR(6),o[1],0,0,0), C1,4); \
    GAPB(o[0]=__builtin_amdgcn_mfma_f32_32x32x16_bf16(PAF(3),VFR(3),o[0],0,0,0), C1,8); \
    GAPB(o[1]=__builtin_amdgcn_mfma_f32_32x32x16_bf16(PAF(3),VFR(7),o[1],0,0,0), C1,12); \
    }while(0)
  int t=1;
  #undef CMASK
  #define CMASK(P0,P1,t) do{}while(0)
  for(;t+5<NT;t+=2){
    STEP(pB0,pB1,pA0,pA1,t,true,true,true);     WAIT_BAR(2); RESC(); ROT();
    STEP(pA0,pA1,pB0,pB1,t+1,true,true,true);   WAIT_BAR(2); RESC(); ROT();
  }
  #undef CMASK
  #define CMASK(P0,P1,t) do{int jb_=(t)-(NT-4); if(jb_>=0)cmask(P0,P1,jb_,qrel,hi);}while(0)
  #define ENDW(tt) do{ if((tt)+3<NT){WAIT_BAR(2);} else if((tt)+2<NT){WAIT_BAR(1);} else {WAIT_BAR(0);} }while(0)
  for(;t+1<NT;t+=2){
    STEP(pB0,pB1,pA0,pA1,t,(t+3<NT),(t+1<NT),(t+1<NT));       ENDW(t);   RESC(); ROT();
    STEP(pA0,pA1,pB0,pB1,t+1,(t+4<NT),(t+2<NT),(t+2<NT));     ENDW(t+1); RESC(); ROT();
  }
  STEP(pB0,pB1,pA0,pA1,NT-1,false,false,false); RESC();
  { float sacc=pB0[0]+pB0[1]; _Pragma("unroll") for(int r=2;r<16;++r)sacc+=pB0[r]; _Pragma("unroll") for(int r=0;r<16;++r)sacc+=pB1[r]; l_reg+=sacc;
    pw0=(u32x4){PKW(pB0,0),PKW(pB0,2),PKW(pB0,4),PKW(pB0,6)};pw1=(u32x4){PKW(pB0,8),PKW(pB0,10),PKW(pB0,12),PKW(pB0,14)};pw2=(u32x4){PKW(pB1,0),PKW(pB1,2),PKW(pB1,4),PKW(pB1,6)};pw3=(u32x4){PKW(pB1,8),PKW(pB1,10),PKW(pB1,12),PKW(pB1,14)};
    SBAR(); pv(o,vb0+sl_cur,PAF(0),PAF(1),PAF(2),PAF(3)); }
  #undef PKW
  #undef PAF
  #undef VFR
  #undef PIN
  #undef MX3
  #undef GAPA
  #undef GAPB
  #undef EX
  #undef VRD
  #undef KRD
  #undef STEP
  #undef ENDW
  {auto rr=__builtin_amdgcn_permlane32_swap(__float_as_uint(l_reg),__float_as_uint(l_reg),false,false);l_reg=__uint_as_float(rr[0])+__uint_as_float(rr[1]);}
  if(hi==0)wsf[32+r32]=l_reg;asm volatile("s_waitcnt lgkmcnt(0)":::"memory");
  float rli[16];
  #pragma unroll
  for(int r=0;r<16;++r)rli[r]=__builtin_amdgcn_rcpf(wsf[32+crow(r,hi)]);
  bf16*Ow=O+(rowbase+q0+wid*QBLK)*OPITCH+h*D; const bf16*Gw=G+(rowbase+q0+wid*QBLK)*DM+h*D;
  { bf16*stg=(bf16*)(shm+LDS_OST)+wid*2048;
    #pragma unroll
    for(int r=0;r<16;++r){const int orow=crow(r,hi);
      #pragma unroll
      for(int d0=0;d0<2;++d0)stg[orow*64+d0*32+r32]=__float2bfloat16(o[d0][r]*rli[r]);}
    asm volatile("s_waitcnt lgkmcnt(0)":::"memory");
    #pragma unroll
    for(int i=0;i<4;++i){const int row=i*8+(lane>>3),ch=lane&7; const u32x4 v=*(const u32x4*)(stg+row*64+ch*8); const u32x4 gv=*(const u32x4*)(Gw+(long)row*DM+ch*8); u32x4 w;
      #pragma unroll
      for(int e=0;e<4;++e){ const float a0=__uint_as_float(v[e]<<16)*__uint_as_float(gv[e]<<16), a1=__uint_as_float(v[e]&0xffff0000u)*__uint_as_float(gv[e]&0xffff0000u); w[e]=cvtpk_s(a0,a1); }
      ATTN_STORE16(Ow+(long)row*OPITCH+ch*8,w);} }
  asm volatile("s_waitcnt lgkmcnt(0)\n\ts_barrier":::"memory");
  #undef DMA_K
  #undef DMA_V
  #undef CMASK
  #undef START
  #undef RESC
  #undef ROT
  #undef BINIT
}
typedef float f32x4w __attribute__((ext_vector_type(4)));
__device__ __forceinline__ void bias_table(char*shm,const float*logf,int b,int h){
  const int tid=tid_fresh(),lane=tid&63,wid=tid>>6; float*ws=(float*)(shm+LDS_WS); float*fs=(float*)(shm+LDS_FS2);
  const float*src=logf+((long)b*SEQ+4*tid)*16+h;
  const float v0=src[0],v1=src[16],v2=src[32],v3=src[48]; const float p0=v0,p1=p0+v1,p2=p1+v2,p3=p2+v3;
  float inc=p3;
  #pragma unroll
  for(int o=1;o<64;o<<=1){ const float y=__shfl_up(inc,o); if(lane>=o)inc+=y; }
  if(lane==63)ws[wid]=inc;
  __syncthreads();
  float woff=0.f;
  #pragma unroll
  for(int w=0;w<8;++w){ const float x=ws[w]; if(w<wid)woff+=x; }
  const float ex=woff+inc-p3; const float L2E=-1.4426950408889634f;
  f32x4w o; o[0]=(ex+p0)*L2E;o[1]=(ex+p1)*L2E;o[2]=(ex+p2)*L2E;o[3]=(ex+p3)*L2E;
  *(f32x4w*)(fs+4*tid)=o;
  __syncthreads();
}
constexpr int ATTN_LDS_BYTES=LDS_BYTES;
struct AttnTensors { const bf16* Q; const bf16* K; const bf16* V; const bf16* G; bf16* O; const float* logf; };
struct AttnUnit { int bh; int qb; };
struct StaticOrder {
  int vcu;
  __device__ __forceinline__ explicit StaticOrder(int grid,int block):vcu((block%8)*(grid/8)+block/8){}
  __device__ __forceinline__ bool next(int i,AttnUnit&u)const{ if(i>=2||vcu>=BATCH*NHEAD*4)return false; const int s=vcu&3; u.bh=vcu>>2; u.qb=(i==0)?7-s:s; return true; }
  __device__ __forceinline__ void a_ready(const AttnUnit&)const{}
  __device__ __forceinline__ void done(const AttnUnit&)const{}
};
template<class Sched,int THRL=8> __device__ __forceinline__ void attn_phase(char*lds,const AttnTensors&T,const Sched&S){
  AttnUnit u;
  if(!S.next(0,u))return;
  bias_table(lds,T.logf,u.bh/NHEAD,u.bh%NHEAD);
  for(int i=0;S.next(i,u);++i){ S.a_ready(u); attn_unit<THRL>(u.bh/NHEAD,u.bh%NHEAD,u.qb,T.Q,T.K,T.V,T.G,T.O,lds); S.done(u); }
}
#undef SBAR
#undef WAIT_BAR
}

constexpr int NWAVES = 8;
constexpr int DMODEL = 2048, NB = 4, SEQ = 2048, MP = NB * SEQ, DB = 8, DS = 8, MS = DB * DS, MT = MP + MS;
constexpr int NH = 16, HD = 64, AW = 1024, PW = 1024, INC = 10256, NIN = 10240, FLC = 6144;
constexpr int PAGE = 128, NPG = 128, PBUF = 15;
constexpr float EPS = 1e-6f, LOG2E = 1.4426950408889634f, C2 = 0.125f * 1.4426950408889634f;
constexpr size_t O_YP = 0, O_YS = O_YP + (size_t)MP * DMODEL, O_KP = O_YS + (size_t)MS * DMODEL, O_VP = O_KP + (size_t)MP * AW, O_LFP = O_VP + (size_t)MP * AW,
                 O_PP = O_LFP + (size_t)MP * NH, O_KS = O_PP + (size_t)NB * PBUF * PW, O_VS = O_KS + (size_t)MS * AW, O_LFS = O_VS + (size_t)MS * AW, O_PS = O_LFS + (size_t)MS * NH,
                 O_END = O_PS + (size_t)DB * PBUF * PW;
constexpr size_t MiB = 1u << 20;
constexpr size_t WS_CTL = 0, CTL_ZERO_BYTES = 1 * MiB;
constexpr size_t WS_WIN = 2 * MiB, WS_WPM = 42 * MiB, WS_WUP = 43 * MiB, WS_WOUT = 51 * MiB;
constexpr size_t WS_XB = 60 * MiB, WS_RINV = 93 * MiB, WS_PSUM = 94 * MiB;
constexpr size_t WS_U = 95 * MiB, WS_GP = 112 * MiB, WS_Q = 129 * MiB, WS_KB = 146 * MiB, WS_VB = 163 * MiB, WS_GA = 180 * MiB, WS_D = 197 * MiB;
constexpr size_t WS_MA = 214 * MiB, WS_MB = 247 * MiB, WS_AB = 280 * MiB, WS_MG = 313 * MiB;
constexpr size_t WS_MA8 = 346 * MiB, WS_MB8 = 364 * MiB;
constexpr size_t WS_P32 = 382 * MiB, WS_PO = 410 * MiB, WS_PML = 418 * MiB, WS_END = 420 * MiB;
constexpr int CW_TMO = 0, CW_CODE = 1, CW_BAR = 4096, CW_QFLAG = 8192;
constexpr int RING_OFF = 0, RING_BYTES = 131072;
constexpr int LDSCTL_OFF = 143360, MISC_OFF = LDSCTL_OFF + 320;
constexpr int LDS_BYTES = 147456;
static_assert(MISC_OFF + 128 <= LDS_BYTES, "LDS map");

#define GAS __attribute__((address_space(1)))
#define LAS __attribute__((address_space(3)))
typedef unsigned short bf16;
typedef unsigned v4u __attribute__((ext_vector_type(4)));
typedef float f32x4 __attribute__((ext_vector_type(4)));
typedef short bf16x8 __attribute__((ext_vector_type(8)));
typedef GAS unsigned gu32;
typedef GAS unsigned long long gu64;
#define RLX_AGENT __ATOMIC_RELAXED, __HIP_MEMORY_SCOPE_AGENT
#define LDS_WAIT() asm volatile("s_waitcnt lgkmcnt(0)" ::: "memory")
#define VM_WAIT() asm volatile("s_waitcnt vmcnt(0)" ::: "memory")
__device__ __forceinline__ unsigned long long rt() { return __builtin_amdgcn_s_memrealtime(); }
__device__ __forceinline__ unsigned f2bf(float f) { unsigned u = __builtin_bit_cast(unsigned, f); return (u + 0x7fffu + ((u >> 16) & 1u)) >> 16; }
__device__ __forceinline__ unsigned pk2(float lo, float hi) { return f2bf(lo) | (f2bf(hi) << 16); }

#define XB_TMO      128
#define XB_XCNT(j)  (256  + 64 * (j))
#define XB_XSUB(j)  (1280 + 64 * (j))
#define XB_XGEN(j)  (2304 + 64 * (j))
#define XB_TOP      3328
#define XB_TOPGEN   3392
#define XCD_BAR_WORDS 3456
#define XB_SPIN_CAP (1u << 18)

__device__ __forceinline__ unsigned xb_ld(unsigned* p)              { return __hip_atomic_load(p, __ATOMIC_RELAXED, __HIP_MEMORY_SCOPE_AGENT); }
__device__ __forceinline__ unsigned xb_add(unsigned* p, unsigned v) { return __hip_atomic_fetch_add(p, v, __ATOMIC_RELAXED, __HIP_MEMORY_SCOPE_AGENT); }
__device__ __forceinline__ unsigned xb_xcc_id() { return (unsigned)__builtin_amdgcn_s_getreg((3 << 11) | 20) & 0xFu; }
#define XB_SPIN(cond, bar) do { unsigned _sp = 0; while (cond) { __builtin_amdgcn_s_sleep(1); \
    if ((++_sp & 255u) == 0u) { if (xb_ld(&(bar)[XB_TMO])) break; if (_sp > XB_SPIN_CAP) { atomicAdd(&(bar)[XB_TMO], 1u); break; } } } } while (0)

struct XcdBarrier {
    unsigned* bar; unsigned x;
    volatile LAS unsigned* st;
};

__device__ __forceinline__ XcdBarrier xcd_barrier_post(unsigned* bar, volatile LAS unsigned* st) {
    XcdBarrier b; b.bar = bar; b.x = xb_xcc_id(); b.st = st;
    if (threadIdx.x == 0) (void)xb_add(&bar[XB_XCNT(b.x)], 1u);
    return b;
}
__device__ __forceinline__ void xcd_barrier_complete(unsigned* bar, unsigned x, unsigned& nloc, unsigned& nx) {
    const unsigned G = gridDim.x * gridDim.y * gridDim.z;
    unsigned sum, cnt, mine, sp = 0u;
    for (;;) {
        sum = 0u; cnt = 0u; mine = 0u;
#pragma unroll
        for (unsigned j = 0; j < 16; ++j) { const unsigned c = xb_ld(&bar[XB_XCNT(j)]); sum += c; cnt += (c > 0u) ? 1u : 0u; mine = (j == x) ? c : mine; }
        if (sum == G) break;
        __builtin_amdgcn_s_sleep(1);
        if ((++sp & 255u) == 0u) { if (xb_ld(&bar[XB_TMO])) break; if (sp > XB_SPIN_CAP) { atomicAdd(&bar[XB_TMO], 1u); break; } }
    }
    nloc = mine > 0u ? mine : 1u; nx = cnt > 0u ? cnt : 1u;
}

__device__ __forceinline__ void xcd_barrier(const XcdBarrier& b) {
    asm volatile("s_waitcnt vmcnt(0)" ::: "memory");
    __syncthreads();
    if (threadIdx.x == 0) {
        unsigned* bar = b.bar;
        __builtin_amdgcn_s_waitcnt(0);
        unsigned nloc = b.st[0], nx = b.st[1];
        if (nloc == 0u) { xcd_barrier_complete(bar, b.x, nloc, nx); b.st[0] = nloc; b.st[1] = nx; }
        const unsigned old = xb_add(&bar[XB_XSUB(b.x)], 1u);
        const unsigned gen = old / nloc;
        if (old + 1u == (gen + 1u) * nloc) {
            __builtin_amdgcn_fence(__ATOMIC_RELEASE, "agent");
            asm volatile("s_waitcnt vmcnt(0)" ::: "memory");
            const unsigned og = xb_add(&bar[XB_TOP], 1u);
            const unsigned tg = og / nx;
            if (og + 1u == (tg + 1u) * nx) xb_add(&bar[XB_TOPGEN], 1u);
            else XB_SPIN(xb_ld(&bar[XB_TOPGEN]) == tg, bar);
            __builtin_amdgcn_fence(__ATOMIC_ACQUIRE, "agent");
            xb_add(&bar[XB_XGEN(b.x)], 1u);
            asm volatile("s_waitcnt vmcnt(0)" ::: "memory");
        } else {
            XB_SPIN(xb_ld(&bar[XB_XGEN(b.x)]) == gen, bar);
            __builtin_amdgcn_fence(__ATOMIC_ACQUIRE, "agent");
            asm volatile("s_waitcnt vmcnt(0)" ::: "memory");
        }
    }
    __syncthreads();
}

struct Args { const float* in[17]; float* out; unsigned char* ws; };
struct Frame {
    LAS unsigned char* lds; volatile LAS unsigned* MISC; gu32* ctl;
    int wave, vcu, G;
    const float *xp, *xs, *cache_k, *cache_v, *cache_lf, *state_pool, *norm_gain, *w_in, *b_f, *qg, *kg, *w_pm, *pool_scale, *w_upp, *w_upa, *w_out; const int* page_table;
    float* out;
    unsigned char* ws;
};
__device__ __forceinline__ float wave_sum(float v) {
#pragma unroll
    for (int o = 1; o < 64; o <<= 1) v += __shfl_xor(v, o);
    return v;
}
__device__ __forceinline__ float wave_max(float v) {
#pragma unroll
    for (int o = 1; o < 64; o <<= 1) v = fmaxf(v, __shfl_xor(v, o));
    return v;
}
constexpr float LOG2E_ = 1.4426950408889634f;
__device__ __forceinline__ float bf_lo(unsigned u) { return __uint_as_float(u << 16); }
__device__ __forceinline__ float bf_hi(unsigned u) { return __uint_as_float(u & 0xffff0000u); }
__device__ __forceinline__ unsigned pkbf(float lo, float hi) { return pg8::cvt_pk_bf16(lo, hi); }
__device__ __forceinline__ unsigned pk4_u8(f32x4 v) { unsigned r = 0u;
    r = __builtin_amdgcn_cvt_pk_u8_f32(v[0], 0u, r); r = __builtin_amdgcn_cvt_pk_u8_f32(v[1], 1u, r); r = __builtin_amdgcn_cvt_pk_u8_f32(v[2], 2u, r); r = __builtin_amdgcn_cvt_pk_u8_f32(v[3], 3u, r); return r; }
__device__ __forceinline__ f32x4 un4_u8(unsigned w) { return (f32x4){(float)(w & 0xffu), (float)((w >> 8) & 0xffu), (float)((w >> 16) & 0xffu), (float)(w >> 24)} * (1.0f / 255.0f); }
__device__ __forceinline__ float sigmoidf_(float x) { return __builtin_amdgcn_rcpf(1.0f + __builtin_amdgcn_exp2f(-LOG2E_ * x)); }
__device__ __forceinline__ float siluf_(float x) { return x * __builtin_amdgcn_rcpf(1.0f + __builtin_amdgcn_exp2f(-LOG2E_ * x)); }
__device__ __forceinline__ float logsigmoidf_(float x) { return fminf(x, 0.f) - log1pf(expf(-fabsf(x))); }

__device__ __forceinline__ int rep_count(int n) { asm volatile("" : "+s"(n)); return n; }
struct TItem { const float* W; const float* gain; bf16* WT; int N, n0, k0, ldt, drow0, drow1; };
constexpr int TI_IN = (DMODEL / 64) * (NIN / 64), TI_PM = 4 * (256 / 64) * (256 / 64), TI_UP = (1024 / 64) * (DMODEL / 64), TI_OUT = (DMODEL / 64) * (DMODEL / 64), TI_ALL = TI_IN + TI_PM + 2 * TI_UP + TI_OUT;
__device__ __forceinline__ TItem p0_item(Frame& F, int it) {
    TItem t; int r = it;
    if (r < TI_IN) { const int kb = r / (NIN / 64), nb = r % (NIN / 64), pn = nb >> 2, wc = nb & 3;
        t.W = F.w_in; t.gain = F.norm_gain; t.WT = (bf16*)(F.ws + WS_WIN); t.N = INC; t.n0 = 256 * pn + 64 * wc + (pn >= 24 ? 16 : 0); t.k0 = 64 * kb; t.ldt = DMODEL; t.drow0 = 256 * pn + 32 * wc; t.drow1 = t.drow0 + 128; return t; } r -= TI_IN;
    t.gain = nullptr;
    if (r < TI_PM) { const int g = r >> 4, q = r & 15, kb = q >> 2, nb = q & 3; t.W = F.w_pm + (size_t)g * 65536; t.WT = (bf16*)(F.ws + WS_WPM) + (size_t)g * 65536; t.N = 256; t.n0 = 64 * nb; t.k0 = 64 * kb; t.ldt = 256; t.drow0 = 64 * nb; t.drow1 = t.drow0 + 32; return t; } r -= TI_PM;
    if (r < 2 * TI_UP) { const int half = r >= TI_UP; r -= half * TI_UP; const int kb = r / (DMODEL / 64), nb = r % (DMODEL / 64); t.W = half ? F.w_upa : F.w_upp; t.WT = (bf16*)(F.ws + WS_WUP) + 1024 * half; t.N = DMODEL; t.n0 = 64 * nb; t.k0 = 64 * kb; t.ldt = DMODEL; t.drow0 = 64 * nb; t.drow1 = t.drow0 + 32; return t; } r -= 2 * TI_UP;
    { const int kb = r / (DMODEL / 64), nb = r % (DMODEL / 64); t.W = F.w_out; t.WT = (bf16*)(F.ws + WS_WOUT); t.N = DMODEL; t.n0 = 64 * nb; t.k0 = 64 * kb; t.ldt = DMODEL; t.drow0 = 64 * nb; t.drow1 = t.drow0 + 32; return t; }
}
__device__ __forceinline__ void p0_item_load(const TItem& t, int lane, f32x4 (&v)[16]) {
    const GAS float* src = (const GAS float*)t.W + (size_t)(t.k0 + (lane >> 4)) * t.N + t.n0 + 4 * (lane & 15);
#pragma unroll
    for (int i = 0; i < 16; ++i) v[i] = __builtin_nontemporal_load((const GAS f32x4*)(src + (size_t)(4 * i) * t.N));
}
__device__ __forceinline__ void p0_item_store(const TItem& t, int lane, LAS float* scr, const f32x4 (&v)[16]) {
    const int kr = lane >> 4, c4 = lane & 15, c = lane & 7;
    f32x4 g0 = (f32x4){1.f, 1.f, 1.f, 1.f}, g1 = g0;
    if (t.gain) { g0 = *(const GAS f32x4*)(t.gain + t.k0 + 8 * c); g1 = *(const GAS f32x4*)(t.gain + t.k0 + 8 * c + 4); }
#pragma unroll
    for (int i = 0; i < 16; ++i) { LAS float* d = scr + (4 * i + kr) * 65 + 4 * c4; d[0] = v[i][0]; d[1] = v[i][1]; d[2] = v[i][2]; d[3] = v[i][3]; }
    LDS_WAIT(); asm volatile("" ::: "memory");
#pragma unroll
    for (int j = 0; j < 8; ++j) { const int n = (lane >> 3) + 8 * j; const LAS float* s = scr + (8 * c) * 65 + n; const int drow = (j < 4) ? t.drow0 + n : t.drow1 + (n - 32);
        v4u o; o.x = pkbf(s[0 * 65] * g0[0], s[1 * 65] * g0[1]); o.y = pkbf(s[2 * 65] * g0[2], s[3 * 65] * g0[3]); o.z = pkbf(s[4 * 65] * g1[0], s[5 * 65] * g1[1]); o.w = pkbf(s[6 * 65] * g1[2], s[7 * 65] * g1[3]);
        *(GAS v4u*)(t.WT + (size_t)drow * t.ldt + t.k0 + 8 * c) = o; }
    LDS_WAIT(); asm volatile("" ::: "memory");
}
__device__ __forceinline__ void p0_row_load(Frame& F, int m, int lane_, f32x4 (&v)[8]) {
    const float* xrow = (m < MP) ? F.xp + (size_t)m * DMODEL : F.xs + (size_t)(m - MP) * DMODEL;
    const GAS f32x4* xr = (const GAS f32x4*)xrow + lane_;
#pragma unroll
    for (int j = 0; j < 8; ++j) v[j] = __builtin_nontemporal_load(xr + 64 * j);
}
__device__ __forceinline__ void p0_row(Frame& F, int m, const LAS unsigned* WF, int lane_, const f32x4 (&v)[8], float bfh) {
    float ss = 0.f;
#pragma unroll
    for (int j = 0; j < 8; ++j) ss += (v[j].x * v[j].x + v[j].y * v[j].y) + (v[j].z * v[j].z + v[j].w * v[j].w);
    ss = wave_sum(ss);
    const float rinv = 1.0f / sqrtf(ss * (1.0f / DMODEL) + EPS);
    GAS unsigned long long* o8 = (GAS unsigned long long*)(((bf16*)(F.ws + WS_XB)) + (size_t)m * DMODEL) + lane_;
    float acc[16];
#pragma unroll
    for (int h = 0; h < 16; ++h) acc[h] = 0.f;
    typedef __bf16 bf16x2_t __attribute__((ext_vector_type(2)));
    typedef unsigned u32x2 __attribute__((ext_vector_type(2)));
#pragma unroll
    for (int j = 0; j < 8; ++j) {
        const unsigned p0 = pkbf(v[j].x, v[j].y), p1 = pkbf(v[j].z, v[j].w);
        o8[64 * j] = (unsigned long long)p0 | ((unsigned long long)p1 << 32);
#pragma unroll
        for (int h = 0; h < 16; ++h) { const unsigned wx = WF[h * 1024 + 128 * j + 2 * lane_], wy = WF[h * 1024 + 128 * j + 2 * lane_ + 1];
            acc[h] = __builtin_amdgcn_fdot2_f32_bf16(__builtin_bit_cast(bf16x2_t, p0), __builtin_bit_cast(bf16x2_t, wx), acc[h], false);
            acc[h] = __builtin_amdgcn_fdot2_f32_bf16(__builtin_bit_cast(bf16x2_t, p1), __builtin_bit_cast(bf16x2_t, wy), acc[h], false); }
    }
#pragma unroll
    for (int st = 0; st < 4; ++st) { const int s = 32 >> st, half = 8 >> st; const bool up = (lane_ & s) != 0;
#pragma unroll
        for (int i = 0; i < half; ++i) { const float send = up ? acc[i] : acc[i + half]; const float keep = up ? acc[i + half] : acc[i]; acc[i] = keep + __shfl_xor(send, s); } }
    float t = acc[0]; t += __shfl_xor(t, 2); t += __shfl_xor(t, 1);
    if ((lane_ & 3) == 0) { const int h = ((lane_ >> 5) & 1) * 8 + ((lane_ >> 4) & 1) * 4 + ((lane_ >> 3) & 1) * 2 + ((lane_ >> 2) & 1);
        const float lf = logsigmoidf_(t * rinv + bfh);
        if (m < MP) F.out[O_LFP + (size_t)m * NH + h] = lf; else F.out[O_LFS + (size_t)(m - MP) * NH + h] = lf; }
    if (lane_ == 0) ((float*)(F.ws + WS_RINV))[m] = rinv;
}
#ifndef FROWS
#define FROWS 1
#endif
constexpr int FUSED_CUS = NIN / 64;
__device__ __forceinline__ void p0_fused_in(Frame& F, int nb);
constexpr int TI_EARLY = TI_IN + TI_PM, LATE_CU0 = NIN / 64;
__device__ __forceinline__ void p0_items(Frame& F, int it0, int end, int stride, int lane_, LAS float* scr) {
    f32x4 va[16], vb[16]; int it = it0;
    TItem ta, tb; if (it < end) { ta = p0_item(F, it); p0_item_load(ta, lane_, va); }
    while (it < end) { int i2 = it + stride; if (i2 < end) { tb = p0_item(F, i2); p0_item_load(tb, lane_, vb); } p0_item_store(ta, lane_, scr, va); it = i2; if (it >= end) break;
        i2 = it + stride; if (i2 < end) { ta = p0_item(F, i2); p0_item_load(ta, lane_, va); } p0_item_store(tb, lane_, scr, vb); it = i2; }
}
__device__ __forceinline__ void p0_prologue(Frame& F) {
    const int tid_ = tid_fresh(), lane_ = tid_ & 63;
    LAS unsigned* WF = (LAS unsigned*)(F.lds + RING_OFF);
    const int gw = F.vcu * NWAVES + F.wave, NGW = F.G * NWAVES;
    const bool fused = (F.G == 256); const int bx_ = (int)blockIdx.x;
    const int RSTEP = fused ? (bx_ < FUSED_CUS ? FUSED_CUS * NWAVES : (256 - FUSED_CUS) * NWAVES) : NGW, REND = (fused && bx_ < FUSED_CUS) ? FROWS * FUSED_CUS * NWAVES : MT;
    f32x4 va[8], vb[8]; int m = fused ? (bx_ < FUSED_CUS ? bx_ * NWAVES + F.wave : FROWS * FUSED_CUS * NWAVES + (bx_ - FUSED_CUS) * NWAVES + F.wave) : gw;
    if (m < REND) p0_row_load(F, m, lane_, va);
    const float bfh = F.b_f[((lane_ >> 5) & 1) * 8 + ((lane_ >> 4) & 1) * 4 + ((lane_ >> 3) & 1) * 2 + ((lane_ >> 2) & 1)];
#pragma unroll
    for (int it = 0; it < 2; ++it) { const int i = tid_ + 512 * it;
        const GAS f32x4* r0 = (const GAS f32x4*)(F.w_in + (size_t)(2 * i) * INC + FLC); const GAS f32x4* r1 = (const GAS f32x4*)(F.w_in + (size_t)(2 * i + 1) * INC + FLC);
        f32x4 a[4], b[4];
#pragma unroll
        for (int q = 0; q < 4; ++q) { a[q] = r0[q]; b[q] = r1[q]; }
        const float ga = F.norm_gain[2 * i], gb = F.norm_gain[2 * i + 1];
#pragma unroll
        for (int q = 0; q < 4; ++q)
#pragma unroll
            for (int e = 0; e < 4; ++e) WF[(4 * q + e) * 1024 + i] = pkbf(a[q][e] * ga, b[q][e] * gb); }
    __syncthreads();
    {
        while (m < REND) { int m2 = m + RSTEP; if (m2 < REND) p0_row_load(F, m2, lane_, vb); p0_row(F, m, WF, lane_, va, bfh); m = m2; if (m >= REND) break;
            m2 = m + RSTEP; if (m2 < REND) p0_row_load(F, m2, lane_, va); p0_row(F, m, WF, lane_, vb, bfh); m = m2; } }
    for (int it = gw; it < DB * NPG; it += NGW) { const int phys = F.page_table[it]; const GAS f32x4* src = (const GAS f32x4*)(F.cache_lf + (size_t)phys * PAGE * NH) + lane_;
        f32x4 s = src[0];
#pragma unroll
        for (int i = 1; i < 8; ++i) s += src[64 * i];
#pragma unroll
        for (int o = 4; o < 64; o <<= 1) { s.x += __shfl_xor(s.x, o); s.y += __shfl_xor(s.y, o); s.z += __shfl_xor(s.z, o); s.w += __shfl_xor(s.w, o); }
        if (lane_ < 4) *(GAS f32x4*)(((float*)(F.ws + WS_PSUM)) + (size_t)it * NH + 4 * lane_) = s; }
    for (int it = gw; it < DB * 7; it += NGW) { const int b = it / 7, r = it % 7; const GAS f32x4* src = (const GAS f32x4*)(F.state_pool + (size_t)(b * PBUF + r + 8) * PW) + lane_;
        GAS f32x4* dst = (GAS f32x4*)(F.out + O_PS + (size_t)(b * PBUF + r) * PW) + lane_;
#pragma unroll
        for (int i = 0; i < 4; ++i) dst[64 * i] = src[64 * i]; }
    __syncthreads();
    LAS float* scr = (LAS float*)(F.lds + F.wave * 16640);
    if (!fused) { p0_items(F, gw, (F.G > LATE_CU0) ? TI_EARLY : TI_ALL, NGW, lane_, scr); return; }
    p0_items(F, TI_IN + gw, TI_EARLY, NGW, lane_, scr);
    if (bx_ < FUSED_CUS) p0_fused_in(F, bx_);
}
__device__ __forceinline__ void p0_late_items(Frame& F, int bx) {
    const int tid_ = tid_fresh(), lane_ = tid_ & 63;
    LAS float* scr = (LAS float*)(F.lds + F.wave * 16640);
    if (F.G == 256) p0_items(F, TI_EARLY + bx * NWAVES + F.wave, TI_ALL, 256 * NWAVES, lane_, scr);
    else p0_items(F, TI_EARLY + (bx - LATE_CU0) * NWAVES + F.wave, TI_ALL, (F.G - LATE_CU0) * NWAVES, lane_, scr);
    __syncthreads();
}

using pg8::Unit; using pg8::f32x4;
typedef unsigned u32x4 __attribute__((ext_vector_type(4)));
__device__ __forceinline__ void st8_bf16(bf16* p, f32x4 a, f32x4 b) { u32x4 w; w.x = pkbf(a[0], a[1]); w.y = pkbf(a[2], a[3]); w.z = pkbf(b[0], b[1]); w.w = pkbf(b[2], b[3]); *(GAS u32x4*)p = w; }
__device__ __forceinline__ void st8_f32(float* p, f32x4 a, f32x4 b) { *(GAS f32x4*)p = a; *(GAS f32x4*)(p + 4) = b; }
__device__ __forceinline__ void ld8_bf16(const bf16* p, f32x4& a, f32x4& b) { const u32x4 w = *(const GAS u32x4*)p; a = (f32x4){bf_lo(w.x), bf_hi(w.x), bf_lo(w.y), bf_hi(w.y)}; b = (f32x4){bf_lo(w.z), bf_hi(w.z), bf_lo(w.w), bf_hi(w.w)}; }

struct SchedIn {
    int G, c, i0, i1; const char* A; const char* B;
    __device__ __forceinline__ bool next(int i, Unit& u) const { if (i0 + i >= i1 || !pg8::static_tile(i0 + i, G, c, MP / 256, NIN / 256, u.pm, u.pn)) return false; u.aux = 0;
        u.a = A + (size_t)u.pm * 256 * DMODEL * 2; u.b = B + (size_t)u.pn * 256 * DMODEL * 2; return true; }
    __device__ __forceinline__ void a_ready(const Unit&) const {} __device__ __forceinline__ void done(const Unit&) const {}
};
struct SchedPool {
    int G, c; const char* A; const char* B;
    __device__ __forceinline__ bool next(int i, Unit& u) const { const int L = i * G + c; if (L >= (MP / 256) * 8) return false; u.pm = L >> 3; u.pn = (L >> 1) & 3; u.aux = L & 1;
        u.a = A + ((size_t)u.pm * 256 * PW + 256 * u.pn) * 2; u.b = B + ((size_t)u.pn * 65536 + (size_t)u.aux * 128 * 256) * 2; return true; }
    __device__ __forceinline__ void a_ready(const Unit&) const {} __device__ __forceinline__ void done(const Unit&) const {}
};
struct SchedUp {
    int G, c; const char* A; const char* B;
    __device__ __forceinline__ bool next(int i, Unit& u) const { if (!pg8::static_tile(i, G, c, MP / 256, DMODEL / 256, u.pm, u.pn)) return false; u.aux = 0;
        u.a = A + (size_t)u.pm * 256 * DMODEL * 2; u.b = B + (size_t)u.pn * 256 * DMODEL * 2; return true; }
    __device__ __forceinline__ void a_ready(const Unit&) const {} __device__ __forceinline__ void done(const Unit&) const {}
};
struct SchedOut {
    int G, c; const char* A; const char* B;
    __device__ __forceinline__ bool next(int i, Unit& u) const { if (!pg8::static_tile(i, G, c, MP / 256, DMODEL / 256, u.pm, u.pn)) return false; u.aux = 0;
        u.a = A + (size_t)u.pm * 256 * DMODEL * 2; u.b = B + (size_t)u.pn * 256 * DMODEL * 2; return true; }
    __device__ __forceinline__ void a_ready(const Unit&) const {} __device__ __forceinline__ void done(const Unit&) const {}
};

struct EpiIn {
    static constexpr int ID = 1; static constexpr bool PERM = true, AFTER_DRAIN = false, HAS_MID = false, HAS_PF = false;
    const float* rinv; bf16 *U, *GP, *Q, *KB, *VB, *GA; unsigned char *MA8, *MB8; float *kout, *vout, *pool; const float *qg, *kg;
    __device__ __forceinline__ void operator()(const f32x4 (&acc)[2][2][4][2], const Unit& u, int wr, int wc, int, int) const {
        const int l_ = tid_fresh() & 63, fr = l_ & 15, fq = l_ >> 4;
        const int pn = u.pn, region = pn < 24 ? (pn >> 2) : (pn < 32 ? 6 : 7);
        int row0 = u.pm * 256 + wr * 64 + fr; asm volatile("" : "+v"(row0));
        const int cb = (pn < 24 ? 256 * (pn & 3) : 256 * ((pn - 24) & 7)) + 64 * wc + 8 * fq;
        float rvs[2][4];
#pragma unroll
        for (int ai = 0; ai < 2; ++ai)
#pragma unroll
            for (int m = 0; m < 4; ++m) rvs[ai][m] = rinv[row0 + ai * 128 + m * 16];
        __builtin_amdgcn_sched_barrier(0);
        if (region == 2 || region == 3) {
            const float* gn = (region == 2) ? qg : kg; const float sc = (region == 2) ? C2 : 1.0f;
            f32x4 g0[2], g1[2];
#pragma unroll
            for (int bj = 0; bj < 2; ++bj) { g0[bj] = *(const GAS f32x4*)(gn + 32 * bj + 8 * fq) * sc; g1[bj] = *(const GAS f32x4*)(gn + 32 * bj + 8 * fq + 4) * sc; }
#pragma unroll
            for (int ai = 0; ai < 2; ++ai)
#pragma unroll
                for (int m = 0; m < 4; ++m) { const int row = row0 + ai * 128 + m * 16; const float rv = rvs[ai][m];
                    f32x4 v[2][2]; float ss = 0.f;
#pragma unroll
                    for (int bj = 0; bj < 2; ++bj)
#pragma unroll
                        for (int n = 0; n < 2; ++n) { v[bj][n] = acc[ai][bj][m][n] * rv; const f32x4 x = v[bj][n]; ss += (x[0] * x[0] + x[1] * x[1]) + (x[2] * x[2] + x[3] * x[3]); }
                    ss += __shfl_xor(ss, 16); ss += __shfl_xor(ss, 32);
                    const float r = __builtin_amdgcn_rsqf(ss * (1.0f / 64.0f) + EPS);
#pragma unroll
                    for (int bj = 0; bj < 2; ++bj) { const f32x4 a = v[bj][0] * r * g0[bj], b = v[bj][1] * r * g1[bj]; const size_t off = (size_t)row * AW + cb + 32 * bj;
                        if (region == 2) st8_bf16(Q + off, a, b); else { st8_f32(kout + off, a, b); st8_bf16(KB + off, a, b); } } }
            return;
        }
#pragma unroll
        for (int ai = 0; ai < 2; ++ai)
#pragma unroll
            for (int m = 0; m < 4; ++m) { const int row = row0 + ai * 128 + m * 16; const float rv = rvs[ai][m];
#pragma unroll
                for (int bj = 0; bj < 2; ++bj) { f32x4 a = acc[ai][bj][m][0] * rv, b = acc[ai][bj][m][1] * rv; const int col = cb + 32 * bj;
                    if (region == 0) { st8_bf16(U + (size_t)row * PW + col, a, b); const int t = row & (SEQ - 1); if (t >= SEQ - PBUF) st8_f32(pool + ((size_t)(row >> 11) * PBUF + (t - (SEQ - PBUF))) * PW + col, a, b); }
                    else if (region == 4) { st8_f32(vout + (size_t)row * AW + col, a, b); st8_bf16(VB + (size_t)row * AW + col, a, b); }
                    else if (region == 1 || region == 5) {
#pragma unroll
                        for (int e = 0; e < 4; ++e) { a[e] = siluf_(a[e]); b[e] = siluf_(b[e]); }
                        st8_bf16((region == 1 ? GP : GA) + (size_t)row * AW + col, a, b); }
                    else {
#pragma unroll
                        for (int e = 0; e < 4; ++e) { a[e] = sigmoidf_(a[e]) * 255.0f; b[e] = sigmoidf_(b[e]) * 255.0f; }
                        typedef unsigned u32x2s __attribute__((ext_vector_type(2)));
                        *(GAS u32x2s*)((region == 6 ? MA8 : MB8) + (size_t)row * DMODEL + col) = (u32x2s){pk4_u8(a), pk4_u8(b)}; } } }
    }
};
struct EpiPool {
    static constexpr int ID = 2; static constexpr bool PERM = true, AFTER_DRAIN = false, HAS_MID = false, HAS_PF = false;
    const float* scale; const bf16* GP; bf16* AB;
    __device__ __forceinline__ void operator()(const f32x4 (&acc)[2][2][4][2], const Unit& u, int wr, int wc, int, int) const {
        const int l_ = tid_fresh() & 63, fr = l_ & 15, fq = l_ >> 4;
        int row0 = u.pm * 256 + wr * 64 + fr, c0 = u.pn * 256 + u.aux * 128 + wc * 32 + 8 * fq; asm volatile("" : "+v"(row0), "+v"(c0));
        const f32x4 s0 = *(const GAS f32x4*)(scale + c0), s1 = *(const GAS f32x4*)(scale + c0 + 4);
        u32x4 gv[2][4];
#pragma unroll
        for (int ai = 0; ai < 2; ++ai)
#pragma unroll
            for (int m = 0; m < 4; ++m) gv[ai][m] = *(const GAS u32x4*)(GP + (size_t)(row0 + ai * 128 + m * 16) * PW + c0);
        __builtin_amdgcn_sched_barrier(0);
#pragma unroll
        for (int ai = 0; ai < 2; ++ai)
#pragma unroll
            for (int m = 0; m < 4; ++m) { const u32x4 w = gv[ai][m]; const f32x4 ga = (f32x4){bf_lo(w.x), bf_hi(w.x), bf_lo(w.y), bf_hi(w.y)}, gb = (f32x4){bf_lo(w.z), bf_hi(w.z), bf_lo(w.w), bf_hi(w.w)};
                st8_bf16(AB + (size_t)(row0 + ai * 128 + m * 16) * DMODEL + c0, acc[ai][0][m][0] * s0 * ga, acc[ai][0][m][1] * s1 * gb); }
    }
};
struct EpiUp {
    static constexpr int ID = 4; static constexpr bool PERM = true, AFTER_DRAIN = false, HAS_MID = true, HAS_PF = false;
    const unsigned char *MA8, *MB8; bf16* MG;
    __device__ __forceinline__ const unsigned char* pf(int it, const Unit& u, int wid, int lane) const { const int L = (it < 3 ? it : 3) * 256 + wid * 32 + (lane >> 1), rem = L & 511;
        return ((L >> 9) ? MB8 : MA8) + (size_t)(u.pm * 256 + (rem >> 1)) * DMODEL + u.pn * 256 + (rem & 1) * 128; }
    typedef unsigned u32x2s __attribute__((ext_vector_type(2)));
    __device__ __forceinline__ void mid(f32x4 (&acc)[2][2][4][2], const Unit& u, int wr, int wc) const {
        const int l_ = tid_fresh() & 63, fr = l_ & 15, fq = l_ >> 4;
        int row0 = u.pm * 256 + wr * 64 + fr, c0 = u.pn * 256 + wc * 32 + 8 * fq; asm volatile("" : "+v"(row0), "+v"(c0));
#pragma unroll
        for (int ai = 0; ai < 2; ++ai) { u32x2s ga[4][2], gb[4][2];
#pragma unroll
            for (int m = 0; m < 4; ++m)
#pragma unroll
                for (int bj = 0; bj < 2; ++bj) { const size_t off = (size_t)(row0 + ai * 128 + m * 16) * DMODEL + c0 + 128 * bj; ga[m][bj] = *(const GAS u32x2s*)(MA8 + off); gb[m][bj] = *(const GAS u32x2s*)(MB8 + off); }
            __builtin_amdgcn_sched_barrier(0);
#pragma unroll
            for (int m = 0; m < 4; ++m)
#pragma unroll
                for (int bj = 0; bj < 2; ++bj) { const f32x4 a0 = un4_u8(ga[m][bj].x), a1 = un4_u8(ga[m][bj].y), b0 = un4_u8(gb[m][bj].x), b1 = un4_u8(gb[m][bj].y);
#pragma unroll
                    for (int e = 0; e < 4; ++e) { acc[ai][bj][m][0][e] *= a0[e] * __builtin_amdgcn_rcpf(fmaxf(b0[e], 1.0e-20f)); acc[ai][bj][m][1][e] *= a1[e] * __builtin_amdgcn_rcpf(fmaxf(b1[e], 1.0e-20f)); } }
            __builtin_amdgcn_sched_barrier(0); }
    }
    __device__ __forceinline__ void operator()(const f32x4 (&acc)[2][2][4][2], const Unit& u, int wr, int wc, int, int) const {
        const int l_ = tid_fresh() & 63, fr = l_ & 15, fq = l_ >> 4;
        int row0 = u.pm * 256 + wr * 64 + fr, c0 = u.pn * 256 + wc * 32 + 8 * fq; asm volatile("" : "+v"(row0), "+v"(c0));
        u32x2s gv[2][4][2];
#pragma unroll
        for (int ai = 0; ai < 2; ++ai)
#pragma unroll
            for (int m = 0; m < 4; ++m)
#pragma unroll
                for (int bj = 0; bj < 2; ++bj) gv[ai][m][bj] = *(const GAS u32x2s*)(MB8 + (size_t)(row0 + ai * 128 + m * 16) * DMODEL + c0 + 128 * bj);
        __builtin_amdgcn_sched_barrier(0);
#pragma unroll
        for (int ai = 0; ai < 2; ++ai)
#pragma unroll
            for (int m = 0; m < 4; ++m)
#pragma unroll
                for (int bj = 0; bj < 2; ++bj) { f32x4 s0 = un4_u8(gv[ai][m][bj].x), s1 = un4_u8(gv[ai][m][bj].y);
#pragma unroll
                    for (int e = 0; e < 4; ++e) { s0[e] = fmaxf(s0[e], 1.0e-20f); s1[e] = fmaxf(s1[e], 1.0e-20f); }
                    st8_bf16(MG + (size_t)(row0 + ai * 128 + m * 16) * DMODEL + c0 + 128 * bj, acc[ai][bj][m][0] * s0, acc[ai][bj][m][1] * s1); }
    }
};
struct EpiOut {
    static constexpr int ID = 8; static constexpr bool PERM = false, AFTER_DRAIN = true, HAS_MID = false, HAS_PF = true;
    const float* x; float* y;
    __device__ __forceinline__ const float* pf(int it, const Unit& u, int wid, int lane) const { const int L = it * 128 + wid * 16 + (lane >> 2); return x + (size_t)(u.pm * 256 + (L >> 3)) * DMODEL + u.pn * 256 + (L & 7) * 32; }
    __device__ __forceinline__ void operator()(const f32x4 (&acc)[2][2][4][2], const Unit& u, int wr, int wc, int, int) const {
        const int l_ = tid_fresh() & 63, fr = l_ & 15, fq = l_ >> 4;
        int row0 = u.pm * 256 + wr * 64 + fr, c0 = u.pn * 256 + wc * 32 + 4 * fq; asm volatile("" : "+v"(row0), "+v"(c0));
#pragma unroll 1
        for (int ai = 0; ai < 2; ++ai)
#pragma unroll
            for (int m = 0; m < 4; ++m)
#pragma unroll
                for (int bj = 0; bj < 2; ++bj) { const size_t off = (size_t)(row0 + ai * 128 + m * 16) * DMODEL + c0 + 128 * bj;
                    const f32x4 xa = *(const GAS f32x4*)(x + off), xb = *(const GAS f32x4*)(x + off + 16);
                    *(GAS f32x4*)(y + off) = xa + (ai ? acc[1][bj][m][0] : acc[0][bj][m][0]); *(GAS f32x4*)(y + off + 16) = xb + (ai ? acc[1][bj][m][1] : acc[0][bj][m][1]); }
    }
    __device__ __forceinline__ void fused(const f32x4 (&acc)[2][2][4][2], const Unit& u, int wr, int wc, int, int, LAS unsigned char* lds, int wid, int) const {
        const int l_ = tid_fresh() & 63, fr = l_ & 15, fq = l_ >> 4;
        int wbase = (wr * 64 + fr) * 1024, rbase = wid * 16 * 1024; asm volatile("" : "+v"(wbase));
#pragma unroll
        for (int ai = 0; ai < 2; ++ai) {
            const size_t g0 = (size_t)(u.pm * 256 + ai * 128 + wid * 16) * DMODEL + u.pn * 256 + 4 * l_;
            f32x4 xa[8], xb[8];
#pragma unroll
            for (int j = 0; j < 8; ++j) xa[j] = *(const GAS f32x4*)(x + g0 + (size_t)j * DMODEL);
#pragma unroll
            for (int m = 0; m < 4; ++m)
#pragma unroll
                for (int bj = 0; bj < 2; ++bj)
#pragma unroll
                    for (int n = 0; n < 2; ++n) *(LAS f32x4*)(lds + wbase + m * 16384 + (((32 * bj + 8 * wc + 4 * n + fq) ^ fr) << 4)) = acc[ai][bj][m][n];
            __syncthreads();
#pragma unroll
            for (int j = 0; j < 8; ++j) xb[j] = *(const GAS f32x4*)(x + g0 + (size_t)(8 + j) * DMODEL);
            __builtin_amdgcn_sched_barrier(0);
#pragma unroll
            for (int j = 0; j < 8; ++j) { const f32x4 v = *(const LAS f32x4*)(lds + rbase + j * 1024 + ((l_ ^ j) << 4)); __builtin_nontemporal_store(xa[j] + v, (GAS f32x4*)(y + g0 + (size_t)j * DMODEL)); }
            __builtin_amdgcn_sched_barrier(0);
#pragma unroll
            for (int j = 0; j < 8; ++j) { const f32x4 v = *(const LAS f32x4*)(lds + rbase + (8 + j) * 1024 + ((l_ ^ (8 + j)) << 4)); __builtin_nontemporal_store(xb[j] + v, (GAS f32x4*)(y + g0 + (size_t)(8 + j) * DMODEL)); }
            __syncthreads();
        }
    }
};

template <int W> __device__ __forceinline__ void pool_diff_rows(Frame& F, int row, int c0) {
    const bf16* U = (const bf16*)(F.ws + WS_U); f32x4 ua, ub; ld8_bf16(U + (size_t)row * PW + c0, ua, ub); f32x4 sa = ua, sb = ub;
    const int t = row & (SEQ - 1); f32x4 a[W - 1], b[W - 1];
#pragma unroll
    for (int j = 1; j < W; ++j) { a[j - 1] = (f32x4){0.f, 0.f, 0.f, 0.f}; b[j - 1] = a[j - 1]; if (j <= t) ld8_bf16(U + (size_t)(row - j) * PW + c0, a[j - 1], b[j - 1]); }
#pragma unroll
    for (int j = 1; j < W; ++j) { sa += a[j - 1]; sb += b[j - 1]; }
    const int nw = (t + 1 < W) ? t + 1 : W; const float inv = 1.0f / (float)nw;
    st8_bf16((bf16*)(F.ws + WS_D) + (size_t)row * PW + c0, sa * inv - ua, sb * inv - ub);
}
template <int W> __device__ __forceinline__ void pool_diff_tile_w(Frame& F, int pm, int g, int tid_) {
    const bf16* U = (const bf16*)(F.ws + WS_U); bf16* D = (bf16*)(F.ws + WS_D);
    const int c0 = 256 * g + 8 * (tid_ & 31), rb = 256 * pm + 16 * (tid_ >> 5), t0 = rb & (SEQ - 1);
    u32x4 u[15 + W];
#pragma unroll
    for (int j = 0; j < 15 + W; ++j) { u[j] = (u32x4){0u, 0u, 0u, 0u}; if (t0 + j - (W - 1) >= 0) u[j] = *(const GAS u32x4*)(U + (size_t)(rb + j - (W - 1)) * PW + c0); }
    f32x4 sa = (f32x4){0.f, 0.f, 0.f, 0.f}, sb = sa;
#pragma unroll
    for (int j = 0; j < W - 1; ++j) { const u32x4 w = u[j]; sa += (f32x4){bf_lo(w.x), bf_hi(w.x), bf_lo(w.y), bf_hi(w.y)}; sb += (f32x4){bf_lo(w.z), bf_hi(w.z), bf_lo(w.w), bf_hi(w.w)}; }
#pragma unroll
    for (int i = 0; i < 16; ++i) { const u32x4 w = u[i + W - 1]; const f32x4 ua = (f32x4){bf_lo(w.x), bf_hi(w.x), bf_lo(w.y), bf_hi(w.y)}, ub = (f32x4){bf_lo(w.z), bf_hi(w.z), bf_lo(w.w), bf_hi(w.w)};
        sa += ua; sb += ub;
        const int t = t0 + i, nw = (t + 1 < W) ? t + 1 : W; const float inv = 1.0f / (float)nw;
        st8_bf16(D + (size_t)(rb + i) * PW + c0, sa * inv - ua, sb * inv - ub);
        const u32x4 o = u[i]; sa -= (f32x4){bf_lo(o.x), bf_hi(o.x), bf_lo(o.y), bf_hi(o.y)}; sb -= (f32x4){bf_lo(o.z), bf_hi(o.z), bf_lo(o.w), bf_hi(o.w)}; }
}
__device__ __forceinline__ void pool_diff_tile(Frame& F, int pm, int g) {
    const int tid_ = tid_fresh();
    if (g == 0) pool_diff_tile_w<2>(F, pm, g, tid_); else if (g == 1) pool_diff_tile_w<4>(F, pm, g, tid_); else if (g == 2) pool_diff_tile_w<8>(F, pm, g, tid_); else pool_diff_tile_w<16>(F, pm, g, tid_);
    asm volatile("s_waitcnt vmcnt(0)" ::: "memory"); __syncthreads();
}
constexpr int PL_D = 0, PL_B = 65536;
template <int W> __device__ __forceinline__ void pool_diff_lds_w(Frame& F, int pm2, int g, int tid_) {
    const bf16* U = (const bf16*)(F.ws + WS_U);
    const int chunk = tid_ & 31, rl = 8 * (tid_ >> 5), c0 = 256 * g + 8 * chunk, rb = 128 * pm2 + rl, t0 = rb & (SEQ - 1);
    u32x4 u[7 + W];
#pragma unroll
    for (int j = 0; j < 7 + W; ++j) { u[j] = (u32x4){0u, 0u, 0u, 0u}; if (t0 + j - (W - 1) >= 0) u[j] = *(const GAS u32x4*)(U + (size_t)(rb + j - (W - 1)) * PW + c0); }
    f32x4 sa = (f32x4){0.f, 0.f, 0.f, 0.f}, sb = sa;
#pragma unroll
    for (int j = 0; j < W - 1; ++j) { const u32x4 w = u[j]; sa += (f32x4){bf_lo(w.x), bf_hi(w.x), bf_lo(w.y), bf_hi(w.y)}; sb += (f32x4){bf_lo(w.z), bf_hi(w.z), bf_lo(w.w), bf_hi(w.w)}; }
#pragma unroll
    for (int i = 0; i < 8; ++i) { const u32x4 w = u[i + W - 1]; const f32x4 ua = (f32x4){bf_lo(w.x), bf_hi(w.x), bf_lo(w.y), bf_hi(w.y)}, ub = (f32x4){bf_lo(w.z), bf_hi(w.z), bf_lo(w.w), bf_hi(w.w)};
        sa += ua; sb += ub;
        const int t = t0 + i, nw = (t + 1 < W) ? t + 1 : W; const float inv = 1.0f / (float)nw;
        const f32x4 a = sa * inv - ua, b = sb * inv - ub; u32x4 o; o.x = pkbf(a[0], a[1]); o.y = pkbf(a[2], a[3]); o.z = pkbf(b[0], b[1]); o.w = pkbf(b[2], b[3]);
        *(LAS u32x4*)(F.lds + PL_D + (rl + i) * 512 + ((chunk ^ ((rl + i) & 15)) << 4)) = o;
        const u32x4 x = u[i]; sa -= (f32x4){bf_lo(x.x), bf_hi(x.x), bf_lo(x.y), bf_hi(x.y)}; sb -= (f32x4){bf_lo(x.z), bf_hi(x.z), bf_lo(x.w), bf_hi(x.w)}; }
}
__device__ __forceinline__ void pool_b_load(Frame& F, int g, int nh, int tid_, u32x4 (&bv)[8]) {
#pragma unroll
    for (int i = 0; i < 8; ++i) { const int idx = i * 512 + tid_, sl = idx >> 5, chunk = idx & 31, col = 32 * (sl >> 5) + pg8::perm32(sl & 31);
        bv[i] = *(const GAS u32x4*)(((const bf16*)(F.ws + WS_WPM)) + (size_t)g * 65536 + (size_t)(128 * nh + col) * 256 + 8 * chunk); }
}
__device__ __forceinline__ void pool_b_store(Frame& F, int tid_, const u32x4 (&bv)[8]) {
#pragma unroll
    for (int i = 0; i < 8; ++i) { const int idx = i * 512 + tid_, sl = idx >> 5, chunk = idx & 31; *(LAS u32x4*)(F.lds + PL_B + sl * 512 + ((chunk ^ (sl & 15)) << 4)) = bv[i]; }
}
__device__ __forceinline__ void pool_mma_epi(Frame& F, int pm2, int g, int nh, int tid_) {
    const int lane = tid_ & 63, r = lane & 15, g4 = lane >> 4, w = F.wave, wm = w & 3, wn = w >> 2;
    f32x4 acc[2][2][2];
#pragma unroll
    for (int mb = 0; mb < 2; ++mb)
#pragma unroll
        for (int q = 0; q < 2; ++q) { acc[mb][q][0] = (f32x4){0.f, 0.f, 0.f, 0.f}; acc[mb][q][1] = acc[mb][q][0]; }
    const LAS unsigned char* ap = F.lds + PL_D + (32 * wm + r) * 512; const LAS unsigned char* bp = F.lds + PL_B + (64 * wn + r) * 512;
#pragma unroll
    for (int ks = 0; ks < 8; ++ks) { const int co = ((4 * ks + g4) ^ r) << 4;
        bf16x8 af[2], bfq[2][2];
#pragma unroll
        for (int mb = 0; mb < 2; ++mb) af[mb] = *(const LAS bf16x8*)(ap + mb * 16 * 512 + co);
#pragma unroll
        for (int q = 0; q < 2; ++q)
#pragma unroll
            for (int n = 0; n < 2; ++n) bfq[q][n] = *(const LAS bf16x8*)(bp + (32 * q + 16 * n) * 512 + co);
#pragma unroll
        for (int mb = 0; mb < 2; ++mb)
#pragma unroll
            for (int q = 0; q < 2; ++q)
#pragma unroll
                for (int n = 0; n < 2; ++n) acc[mb][q][n] = __builtin_amdgcn_mfma_f32_16x16x32_bf16(bfq[q][n], af[mb], acc[mb][q][n], 0, 0, 0); }
    const bf16* GP = (const bf16*)(F.ws + WS_GP); bf16* AB = (bf16*)(F.ws + WS_AB);
#pragma unroll
    for (int q = 0; q < 2; ++q) { const int c0 = 256 * g + 128 * nh + 64 * wn + 32 * q + 8 * g4;
        const f32x4 s0 = *(const GAS f32x4*)(F.pool_scale + c0), s1 = *(const GAS f32x4*)(F.pool_scale + c0 + 4);
#pragma unroll
        for (int mb = 0; mb < 2; ++mb) { const size_t row = (size_t)(128 * pm2 + 32 * wm + 16 * mb + r); f32x4 ga, gb; ld8_bf16(GP + row * PW + c0, ga, gb);
            st8_bf16(AB + row * DMODEL + c0, acc[mb][q][0] * s0 * ga, acc[mb][q][1] * s1 * gb); } }
}
__device__ __forceinline__ void pool_unit_lds(Frame& F, int unit) {
    const int tid_ = tid_fresh(), g = (unit >> 1) & 3, pm2 = 2 * (unit >> 3) + (unit & 1);
    u32x4 bv[8]; pool_b_load(F, g, 0, tid_, bv);
    if (g == 0) pool_diff_lds_w<2>(F, pm2, g, tid_); else if (g == 1) pool_diff_lds_w<4>(F, pm2, g, tid_); else if (g == 2) pool_diff_lds_w<8>(F, pm2, g, tid_); else pool_diff_lds_w<16>(F, pm2, g, tid_);
    pool_b_store(F, tid_, bv);
    __syncthreads();
    pool_b_load(F, g, 1, tid_, bv);
    pool_mma_epi(F, pm2, g, 0, tid_);
    __syncthreads();
    pool_b_store(F, tid_, bv);
    __syncthreads();
    pool_mma_epi(F, pm2, g, 1, tid_);
    __syncthreads();
}
template <int W> __device__ __forceinline__ void pool_diff_sample_w(Frame& F, int g, int tid_) {
    const bf16* U = (const bf16*)(F.ws + WS_U); bf16* D = (bf16*)(F.ws + WS_D);
    const int b8 = tid_ >> 5, c0 = 256 * g + 8 * (tid_ & 31);
    f32x4 za[W - 1 + 8], zb[W - 1 + 8];
#pragma unroll
    for (int j = 0; j < W - 1; ++j) { const float* sp = F.state_pool + ((size_t)b8 * PBUF + PBUF - (W - 1) + j) * PW + c0; za[j] = *(const GAS f32x4*)sp; zb[j] = *(const GAS f32x4*)(sp + 4); }
#pragma unroll
    for (int i = 0; i < 8; ++i) ld8_bf16(U + (size_t)(MP + b8 * DS + i) * PW + c0, za[W - 1 + i], zb[W - 1 + i]);
    f32x4 sa = (f32x4){0.f, 0.f, 0.f, 0.f}, sb = sa;
#pragma unroll
    for (int j = 0; j < W - 1; ++j) { sa += za[j]; sb += zb[j]; }
    const float inv = 1.0f / (float)W;
#pragma unroll
    for (int i = 0; i < 8; ++i) { sa += za[W - 1 + i]; sb += zb[W - 1 + i];
        st8_bf16(D + (size_t)(MP + b8 * DS + i) * PW + c0, sa * inv - za[W - 1 + i], sb * inv - zb[W - 1 + i]);
        sa -= za[i]; sb -= zb[i]; }
}
__device__ __forceinline__ void pool_diff_sample(Frame& F, int g) {
    const int tid_ = tid_fresh();
    if (tid_ < 256) { if (g == 0) pool_diff_sample_w<2>(F, g, tid_); else if (g == 1) pool_diff_sample_w<4>(F, g, tid_); else if (g == 2) pool_diff_sample_w<8>(F, g, tid_); else pool_diff_sample_w<16>(F, g, tid_); }
    asm volatile("s_waitcnt vmcnt(0)" ::: "memory"); __syncthreads();
}
__device__ __forceinline__ void q_publish(Frame& F) {
    asm volatile("s_waitcnt vmcnt(0)" ::: "memory"); __syncthreads();
    if (threadIdx.x == 0) { __builtin_amdgcn_fence(__ATOMIC_RELEASE, "agent"); asm volatile("s_waitcnt vmcnt(0)" ::: "memory");
        __hip_atomic_fetch_add(F.ctl + CW_QFLAG, 1u, __ATOMIC_RELAXED, __HIP_MEMORY_SCOPE_AGENT); }
}
__device__ __forceinline__ void q_wait(Frame& F) {
    if (threadIdx.x == 0) { unsigned sp = 0;
        while (__hip_atomic_load(F.ctl + CW_QFLAG, __ATOMIC_RELAXED, __HIP_MEMORY_SCOPE_AGENT) < 16u) { __builtin_amdgcn_s_sleep(4);
            if (++sp > (1u << 22)) { __hip_atomic_store(F.ctl + CW_TMO, 1u, __ATOMIC_RELAXED, __HIP_MEMORY_SCOPE_AGENT); break; } }
        __builtin_amdgcn_fence(__ATOMIC_ACQUIRE, "agent"); asm volatile("s_waitcnt vmcnt(0)" ::: "memory"); }
    __syncthreads();
}

constexpr int SK_PITCH = 68, SK_TILE = 64 * SK_PITCH * 4;
template <int K, class BRow> __device__ __forceinline__ void skinny_mma(const bf16* A, int lda, int ldb, const BRow& brow, LAS unsigned char* lds, int wave, int tid, f32x4& ra, f32x4& rb) {
    const int lane = tid & 63, r = lane & 15, g = lane >> 4; constexpr int KW = K / 8, NKS = KW / 32, BATCH = NKS < 4 ? NKS : 4;
    const GAS bf16* ap = (const GAS bf16*)A + (size_t)r * lda + wave * KW + 8 * g;
    const GAS bf16* bp[4];
#pragma unroll
    for (int nb = 0; nb < 4; ++nb) bp[nb] = (const GAS bf16*)brow(nb) + (size_t)r * ldb + wave * KW + 8 * g;
    f32x4 acc[4][4];
#pragma unroll
    for (int mb = 0; mb < 4; ++mb)
#pragma unroll
        for (int nb = 0; nb < 4; ++nb) acc[mb][nb] = (f32x4){0.f, 0.f, 0.f, 0.f};
#pragma unroll
    for (int k0 = 0; k0 < NKS; k0 += BATCH) { bf16x8 af[BATCH][4], bf[BATCH][4];
#pragma unroll
        for (int ks = 0; ks < BATCH; ++ks)
#pragma unroll
            for (int q = 0; q < 4; ++q) { af[ks][q] = *(const GAS bf16x8*)(ap + (size_t)(16 * q) * lda + 32 * (k0 + ks)); bf[ks][q] = *(const GAS bf16x8*)(bp[q] + 32 * (k0 + ks)); }
        __builtin_amdgcn_sched_barrier(0);
#pragma unroll
        for (int ks = 0; ks < BATCH; ++ks)
#pragma unroll
            for (int mb = 0; mb < 4; ++mb)
#pragma unroll
                for (int nb = 0; nb < 4; ++nb) acc[mb][nb] = __builtin_amdgcn_mfma_f32_16x16x32_bf16(af[ks][mb], bf[ks][nb], acc[mb][nb], 0, 0, 0); }
    LAS float* tile = (LAS float*)(lds + wave * SK_TILE);
#pragma unroll
    for (int mb = 0; mb < 4; ++mb)
#pragma unroll
        for (int nb = 0; nb < 4; ++nb)
#pragma unroll
            for (int i = 0; i < 4; ++i) tile[(16 * mb + 4 * g + i) * SK_PITCH + 16 * nb + r] = acc[mb][nb][i];
    __syncthreads();
    const int srow = tid >> 3, cg = tid & 7; ra = (f32x4){0.f, 0.f, 0.f, 0.f}; rb = ra;
#pragma unroll
    for (int w = 0; w < 8; ++w) { const LAS f32x4* p = (const LAS f32x4*)(lds + w * SK_TILE + (srow * SK_PITCH + 8 * cg) * 4); ra += p[0]; rb += p[1]; }
    __syncthreads();
}

__device__ __forceinline__ void sample_in_epilogue(Frame& F, int su, int tid_, f32x4 a, f32x4 b, float rv);
__device__ __forceinline__ void sample_in_unit(Frame& F, int su) {
    const int tid_ = tid_fresh(), lane_ = tid_ & 63;
    const int pn = su >> 2, wcu = su & 3, region = su >> 4;
    const bf16* Bbase = ((bf16*)(F.ws + WS_WIN)) + (size_t)(256 * pn + 32 * wcu) * DMODEL;
    auto brow = [&](int nb) { return Bbase + (size_t)(128 * (nb >> 1) + 16 * (nb & 1)) * DMODEL; };
    f32x4 a, b; skinny_mma<DMODEL>(((bf16*)(F.ws + WS_XB)) + (size_t)MP * DMODEL, DMODEL, DMODEL, brow, F.lds, F.wave, tid_, a, b);
    sample_in_epilogue(F, su, tid_, a, b, ((float*)(F.ws + WS_RINV))[MP + (tid_ >> 3)]);
    __syncthreads();
}
__device__ __forceinline__ void sample_in_epilogue(Frame& F, int su, int tid_, f32x4 a, f32x4 b, float rv) {
    const int region = su >> 4, srow = tid_ >> 3, cg = tid_ & 7, row = MP + srow;
    a = a * rv; b = b * rv;
    const int col = 64 * (su & 15) + 8 * cg;
    if (region == 0) { st8_bf16(((bf16*)(F.ws + WS_U)) + (size_t)row * PW + col, a, b); st8_f32(F.out + O_PS + ((size_t)(srow >> 3) * PBUF + 7 + (srow & 7)) * PW + col, a, b); }
    else if (region == 1 || region == 5) {
#pragma unroll
        for (int e = 0; e < 4; ++e) { a[e] = siluf_(a[e]); b[e] = siluf_(b[e]); }
        st8_bf16((region == 1 ? ((bf16*)(F.ws + WS_GP)) : ((bf16*)(F.ws + WS_GA))) + (size_t)row * AW + col, a, b); }
    else if (region == 2 || region == 3) {
        float ss = (a[0] * a[0] + a[1] * a[1]) + (a[2] * a[2] + a[3] * a[3]) + (b[0] * b[0] + b[1] * b[1]) + (b[2] * b[2] + b[3] * b[3]);
        ss += __shfl_xor(ss, 1); ss += __shfl_xor(ss, 2); ss += __shfl_xor(ss, 4);
        const float r = 1.0f / sqrtf(ss * (1.0f / 64.0f) + EPS); const float* gn = (region == 2) ? F.qg : F.kg; const float sc = (region == 2) ? C2 : 1.0f;
        const f32x4 g0 = *(const GAS f32x4*)(gn + 8 * cg), g1 = *(const GAS f32x4*)(gn + 8 * cg + 4);
        a = a * r * g0 * sc; b = b * r * g1 * sc;
        if (region == 2) st8_bf16(((bf16*)(F.ws + WS_Q)) + (size_t)row * AW + col, a, b); else { st8_f32(F.out + O_KS + (size_t)srow * AW + col, a, b); st8_bf16(((bf16*)(F.ws + WS_KB)) + (size_t)row * AW + col, a, b); } }
    else if (region == 4) { st8_f32(F.out + O_VS + (size_t)srow * AW + col, a, b); st8_bf16(((bf16*)(F.ws + WS_VB)) + (size_t)row * AW + col, a, b); }
    else { const int col2 = 64 * ((su - 96) & 31) + 8 * cg;
#pragma unroll
        for (int e = 0; e < 4; ++e) { a[e] = sigmoidf_(a[e]); b[e] = sigmoidf_(b[e]); }
        st8_bf16((su < 128 ? ((bf16*)(F.ws + WS_MA)) : ((bf16*)(F.ws + WS_MB))) + (size_t)row * DMODEL + col2, a, b); }
}
__device__ __forceinline__ void p0_fused_in(Frame& F, int nb) {
    const int tid_ = tid_fresh(), lane = tid_ & 63, r = lane & 15, g4 = lane >> 4, w = F.wave;
    LAS float* scr = (LAS float*)(F.lds + w * 16640);
    f32x4 acc[4][4]; float ss[4];
#pragma unroll
    for (int mb = 0; mb < 4; ++mb) { ss[mb] = 0.f;
#pragma unroll
        for (int nbk = 0; nbk < 4; ++nbk) acc[mb][nbk] = (f32x4){0.f, 0.f, 0.f, 0.f}; }
    TItem t = p0_item(F, w * (NIN / 64) + nb);
    f32x4 v[16]; p0_item_load(t, lane, v);
#pragma unroll 1
    for (int i = 0; i < 4; ++i) {
        f32x4 xa[4][2][2];
#pragma unroll
        for (int mb = 0; mb < 4; ++mb)
#pragma unroll
            for (int half = 0; half < 2; ++half) { const GAS f32x4* px = (const GAS f32x4*)(F.xs + (size_t)(16 * mb + r) * DMODEL + t.k0 + 32 * half + 8 * g4); xa[mb][half][0] = px[0]; xa[mb][half][1] = px[1]; }
        { const int kr = lane >> 4, c4 = lane & 15;
#pragma unroll
            for (int i2 = 0; i2 < 16; ++i2) { LAS float* d = scr + (4 * i2 + kr) * 65 + 4 * c4; d[0] = v[i2][0]; d[1] = v[i2][1]; d[2] = v[i2][2]; d[3] = v[i2][3]; } }
        bf16x8 af[4][2];
#pragma unroll
        for (int mb = 0; mb < 4; ++mb)
#pragma unroll
            for (int half = 0; half < 2; ++half) { const f32x4 p = xa[mb][half][0], q = xa[mb][half][1];
                ss[mb] += (p[0] * p[0] + p[1] * p[1]) + (p[2] * p[2] + p[3] * p[3]) + (q[0] * q[0] + q[1] * q[1]) + (q[2] * q[2] + q[3] * q[3]);
                u32x4 o; o.x = pkbf(p[0], p[1]); o.y = pkbf(p[2], p[3]); o.z = pkbf(q[0], q[1]); o.w = pkbf(q[2], q[3]); af[mb][half] = __builtin_bit_cast(bf16x8, o); }
        const TItem tc = t;
        if (i + 1 < 4) { t = p0_item(F, (w + 8 * (i + 1)) * (NIN / 64) + nb); p0_item_load(t, lane, v); }
        LDS_WAIT(); asm volatile("" ::: "memory");
#pragma unroll
        for (int half = 0; half < 2; ++half) { const int kk = 32 * half + 8 * g4;
            const f32x4 g0 = *(const GAS f32x4*)(tc.gain + tc.k0 + kk), g1 = *(const GAS f32x4*)(tc.gain + tc.k0 + kk + 4);
#pragma unroll
            for (int nbk = 0; nbk < 4; ++nbk) { const int n = 16 * nbk + r; const LAS float* sp = scr + kk * 65 + n; const int drow = (nbk < 2) ? tc.drow0 + n : tc.drow1 + (n - 32);
                u32x4 o; o.x = pkbf(sp[0 * 65] * g0[0], sp[1 * 65] * g0[1]); o.y = pkbf(sp[2 * 65] * g0[2], sp[3 * 65] * g0[3]); o.z = pkbf(sp[4 * 65] * g1[0], sp[5 * 65] * g1[1]); o.w = pkbf(sp[6 * 65] * g1[2], sp[7 * 65] * g1[3]);
                *(GAS u32x4*)(tc.WT + (size_t)drow * tc.ldt + tc.k0 + kk) = o;
                const bf16x8 bfr = __builtin_bit_cast(bf16x8, o);
#pragma unroll
                for (int mb = 0; mb < 4; ++mb) acc[mb][nbk] = __builtin_amdgcn_mfma_f32_16x16x32_bf16(af[mb][half], bfr, acc[mb][nbk], 0, 0, 0); } }
        LDS_WAIT(); asm volatile("" ::: "memory");
    }
#pragma unroll
    for (int mb = 0; mb < 4; ++mb) { ss[mb] += __shfl_xor(ss[mb], 16); ss[mb] += __shfl_xor(ss[mb], 32); }
    __syncthreads();
    LAS float* tile = (LAS float*)(F.lds + w * SK_TILE); LAS float* ssl = (LAS float*)(F.lds + 8 * SK_TILE);
#pragma unroll
    for (int mb = 0; mb < 4; ++mb)
#pragma unroll
        for (int nbk = 0; nbk < 4; ++nbk)
#pragma unroll
            for (int i = 0; i < 4; ++i) tile[(16 * mb + 4 * g4 + i) * SK_PITCH + 16 * nbk + r] = acc[mb][nbk][i];
    if (g4 == 0) {
#pragma unroll
        for (int mb = 0; mb < 4; ++mb) ssl[w * 64 + 16 * mb + r] = ss[mb]; }
    __syncthreads();
    const int srow = tid_ >> 3, cg = tid_ & 7; f32x4 ra = (f32x4){0.f, 0.f, 0.f, 0.f}, rb = ra; float sst = 0.f;
#pragma unroll
    for (int ww = 0; ww < 8; ++ww) { const LAS f32x4* p = (const LAS f32x4*)(F.lds + ww * SK_TILE + (srow * SK_PITCH + 8 * cg) * 4); ra += p[0]; rb += p[1]; sst += ssl[ww * 64 + srow]; }
    sample_in_epilogue(F, nb, tid_, ra, rb, 1.0f / sqrtf(sst * (1.0f / DMODEL) + EPS));
    __syncthreads();
}
__device__ __forceinline__ void sample_pool_unit(Frame& F, int j) {
    const int tid_ = tid_fresh(), lane_ = tid_ & 63;
    const int g = j >> 2, q4 = j & 3; const bf16* Bbase = ((bf16*)(F.ws + WS_WPM)) + (size_t)g * 65536 + (size_t)(64 * q4) * 256;
    pool_diff_sample(F, g);
    auto brow = [&](int nb) { return Bbase + (size_t)(16 * nb) * 256; };
    f32x4 a, b, ga, gb; skinny_mma<256>(((bf16*)(F.ws + WS_D)) + (size_t)MP * PW + 256 * g, PW, 256, brow, F.lds, F.wave, tid_, a, b);
    const int srow = tid_ >> 3, cg = tid_ & 7, row = MP + srow, col = 256 * g + 64 * q4 + 8 * cg;
    const f32x4 s0 = *(const GAS f32x4*)(F.pool_scale + col), s1 = *(const GAS f32x4*)(F.pool_scale + col + 4); ld8_bf16(((bf16*)(F.ws + WS_GP)) + (size_t)row * PW + col, ga, gb);
    st8_bf16(((bf16*)(F.ws + WS_AB)) + (size_t)row * DMODEL + col, a * s0 * ga, b * s1 * gb);
    __syncthreads();
}
constexpr int SK16_TILE = 16 * 33 * 4;
__device__ __forceinline__ void skinny16(const bf16* A, const bf16* B, LAS unsigned char* lds, int wave, int tid, float& lo, float& hi) {
    const int lane = tid & 63, r = lane & 15, g = lane >> 4;
    const GAS bf16* ap = (const GAS bf16*)A + (size_t)r * DMODEL + wave * 256 + 8 * g;
    const GAS bf16* bp = (const GAS bf16*)B + (size_t)r * DMODEL + wave * 256 + 8 * g;
    bf16x8 af[8], b0[8], b1[8];
#pragma unroll
    for (int ks = 0; ks < 8; ++ks) { af[ks] = *(const GAS bf16x8*)(ap + 32 * ks); b0[ks] = *(const GAS bf16x8*)(bp + 32 * ks); b1[ks] = *(const GAS bf16x8*)(bp + (size_t)16 * DMODEL + 32 * ks); }
    __builtin_amdgcn_sched_barrier(0);
    f32x4 acc0 = (f32x4){0.f, 0.f, 0.f, 0.f}, acc1 = acc0;
#pragma unroll
    for (int ks = 0; ks < 8; ++ks) { acc0 = __builtin_amdgcn_mfma_f32_16x16x32_bf16(af[ks], b0[ks], acc0, 0, 0, 0); acc1 = __builtin_amdgcn_mfma_f32_16x16x32_bf16(af[ks], b1[ks], acc1, 0, 0, 0); }
    LAS float* tile = (LAS float*)(lds + wave * SK16_TILE);
#pragma unroll
    for (int i = 0; i < 4; ++i) { tile[(4 * g + i) * 33 + r] = acc0[i]; tile[(4 * g + i) * 33 + 16 + r] = acc1[i]; }
    __syncthreads();
    const int e = (tid >> 5) * 33 + (tid & 31); lo = 0.f; hi = 0.f;
#pragma unroll
    for (int w = 0; w < 4; ++w) { lo += ((const LAS float*)(lds + w * SK16_TILE))[e]; hi += ((const LAS float*)(lds + (4 + w) * SK16_TILE))[e]; }
    __syncthreads();
}
__device__ __forceinline__ void sample_up_sub(Frame& F, int id) {
    const int tid_ = tid_fresh(), rg = (id >> 3) & 3, cgp = (id & 7) + 8 * (id >> 5);
    float lo, hi; skinny16(((bf16*)(F.ws + WS_AB)) + (size_t)(MP + 16 * rg) * DMODEL, ((bf16*)(F.ws + WS_WUP)) + (size_t)(32 * cgp) * DMODEL, F.lds, F.wave, tid_, lo, hi);
    const size_t o = (size_t)(MP + 16 * rg + (tid_ >> 5)) * DMODEL + 32 * cgp + (tid_ & 31);
    const float ma = bf_lo(((const GAS bf16*)(F.ws + WS_MA))[o]), mb = bf_lo(((const GAS bf16*)(F.ws + WS_MB))[o]);
    ((GAS bf16*)(F.ws + WS_MG))[o] = (bf16)(pkbf(lo * ma + hi * mb, 0.f) & 0xffffu);
}
__device__ __forceinline__ void sample_out_sub(Frame& F, int id) {
    const int tid_ = tid_fresh(), rg = (id >> 3) & 3, cgp = (id & 7) + 8 * (id >> 5);
    float lo, hi; skinny16(((bf16*)(F.ws + WS_MG)) + (size_t)(MP + 16 * rg) * DMODEL, ((bf16*)(F.ws + WS_WOUT)) + (size_t)(32 * cgp) * DMODEL, F.lds, F.wave, tid_, lo, hi);
    const size_t o = (size_t)(16 * rg + (tid_ >> 5)) * DMODEL + 32 * cgp + (tid_ & 31);
    ((GAS float*)(F.out + O_YS))[o] = ((const GAS float*)F.xs)[o] + (lo + hi);
}
__device__ __forceinline__ void sample_up_unit(Frame& F, int j) {
    const int tid_ = tid_fresh(), lane_ = tid_ & 63;
    const bf16* B0 = ((bf16*)(F.ws + WS_WUP)) + (size_t)(64 * j) * DMODEL; const bf16* B1 = B0 + 1024;
    auto brow0 = [&](int nb) { return B0 + (size_t)(16 * nb) * DMODEL; }; auto brow1 = [&](int nb) { return B1 + (size_t)(16 * nb) * DMODEL; };
    f32x4 a, b, c, d, ma, mb2, na, nb2;
    skinny_mma<1024>(((bf16*)(F.ws + WS_AB)) + (size_t)MP * DMODEL, DMODEL, DMODEL, brow0, F.lds, F.wave, tid_, a, b);
    skinny_mma<1024>(((bf16*)(F.ws + WS_AB)) + (size_t)MP * DMODEL + 1024, DMODEL, DMODEL, brow1, F.lds, F.wave, tid_, c, d);
    const int srow = tid_ >> 3, cg = tid_ & 7, row = MP + srow, col = 64 * j + 8 * cg;
    ld8_bf16(((bf16*)(F.ws + WS_MA)) + (size_t)row * DMODEL + col, ma, mb2); ld8_bf16(((bf16*)(F.ws + WS_MB)) + (size_t)row * DMODEL + col, na, nb2);
    st8_bf16(((bf16*)(F.ws + WS_MG)) + (size_t)row * DMODEL + col, a * ma + c * na, b * mb2 + d * nb2);
    __syncthreads();
}
__device__ __forceinline__ void sample_out_unit(Frame& F, int j) {
    const int tid_ = tid_fresh(), lane_ = tid_ & 63;
    const bf16* B0 = ((bf16*)(F.ws + WS_WOUT)) + (size_t)(64 * j) * DMODEL; auto brow = [&](int nb) { return B0 + (size_t)(16 * nb) * DMODEL; };
    f32x4 a, b; skinny_mma<DMODEL>(((bf16*)(F.ws + WS_MG)) + (size_t)MP * DMODEL, DMODEL, DMODEL, brow, F.lds, F.wave, tid_, a, b);
    const int srow = tid_ >> 3, cg = tid_ & 7, col = 64 * j + 8 * cg;
    const f32x4 xa = *(const GAS f32x4*)(F.xs + (size_t)srow * DMODEL + col), xb = *(const GAS f32x4*)(F.xs + (size_t)srow * DMODEL + col + 4);
    st8_f32(F.out + O_YS + (size_t)srow * DMODEL + col, xa + a, xb + b);
    __syncthreads();
}

constexpr float NEGBIG = -1.0e30f;
#ifndef DEC_AUX
#define DEC_AUX 18
#endif
typedef float f32x2_cv __attribute__((ext_vector_type(2))); typedef __bf16 bf16x2_cv __attribute__((ext_vector_type(2)));
__device__ __forceinline__ unsigned pkbf_c(float lo, float hi) { f32x2_cv v = {lo, hi}; bf16x2_cv b = __builtin_convertvector(v, bf16x2_cv); return __builtin_bit_cast(unsigned, b); }
__device__ __forceinline__ float xg_max(float x) {
    auto s = __builtin_amdgcn_permlane16_swap(__float_as_uint(x), __float_as_uint(x), false, false); x = fmaxf(__uint_as_float(s[0]), __uint_as_float(s[1]));
    auto t = __builtin_amdgcn_permlane32_swap(__float_as_uint(x), __float_as_uint(x), false, false); return fmaxf(__uint_as_float(t[0]), __uint_as_float(t[1])); }
constexpr int DEC_VPITCH = 160, DEC_IMG = 32 * DEC_VPITCH, DEC_WAVE_LDS = 4096 + 2 * DEC_IMG;
typedef short v4i16_t __attribute__((ext_vector_type(4)));
template <bool PROBE = false> __device__ __forceinline__ void decode_partials(Frame& F) {
    const int tid_ = tid_fresh(), lane_ = tid_ & 63;
    const int c = F.vcu; if (c >= DB * 32) return;
    const int b = c >> 5, sp = c & 31, lane = lane_, n = lane & 15, g = lane >> 4, w = F.wave;
    LAS float* btab = (LAS float*)(F.lds + w * DEC_WAVE_LDS);
    LAS unsigned char* kimg = F.lds + w * DEC_WAVE_LDS + 4096; LAS unsigned char* vimg = kimg + DEC_IMG;
    int phys[4];
#pragma unroll
    for (int p = 0; p < 4; ++p) phys[p] = __builtin_amdgcn_readfirstlane(F.page_table[b * NPG + sp + 32 * p]);
    typedef unsigned u32x2 __attribute__((ext_vector_type(2)));
#pragma unroll
    for (int hh = 0; hh < 2; ++hh) { const int h = w + 8 * hh;
        const float* ps = ((float*)(F.ws + WS_PSUM)) + (size_t)b * NPG * NH + h; const float x0 = ps[(size_t)lane * NH], x1 = ps[(size_t)(lane + 64) * NH];
#pragma unroll
        for (int p = 0; p < 4; ++p) { const int pg = sp + 32 * p; const float later = wave_sum(((lane > pg) ? x0 : 0.f) + ((lane + 64 > pg) ? x1 : 0.f));
            const float* lf = F.cache_lf + (size_t)phys[p] * PAGE * NH + h; const float a = lf[(size_t)(2 * lane) * NH], bq = lf[(size_t)(2 * lane + 1) * NH];
            float inc = a + bq;
#pragma unroll
            for (int o = 1; o < 64; o <<= 1) { const float y = __shfl_down(inc, o); if (lane + o < 64) inc += y; }
            const float ex = inc - (a + bq);
            btab[(p * 2 + hh) * 128 + 2 * lane] = (later + ex + bq) * LOG2E; btab[(p * 2 + hh) * 128 + 2 * lane + 1] = (later + ex) * LOG2E; }
    }
    LDS_WAIT();
    const __amdgpu_buffer_rsrc_t rsk = __builtin_amdgcn_make_buffer_rsrc((void*)F.cache_k, 0, (int)((size_t)1280 * PAGE * NH * HD * 4), 0x00020000);
    const __amdgpu_buffer_rsrc_t rsv = __builtin_amdgcn_make_buffer_rsrc((void*)F.cache_v, 0, (int)((size_t)1280 * PAGE * NH * HD * 4), 0x00020000);
    const int iwr = (lane >> 4) * DEC_VPITCH + 8 * (lane & 15);
    const int krd = n * DEC_VPITCH + 16 * g;
    const int vrd = (4 * g + ((lane & 15) >> 2)) * DEC_VPITCH + 8 * (lane & 3);
    for (int hh = 0; hh < 2; ++hh) { const int h = w + 8 * hh;
        bf16x8 qf[2];
        { const bf16* qrow = ((bf16*)(F.ws + WS_Q)) + (size_t)(MP + b * DS + (n & 7)) * AW + h * HD;
#pragma unroll
            for (int half = 0; half < 2; ++half) { u32x4 qv = *(const GAS u32x4*)(qrow + 32 * half + 8 * g); if (n >= 8) qv = (u32x4){0u, 0u, 0u, 0u}; qf[half] = __builtin_bit_cast(bf16x8, qv); } }
        float mrun = NEGBIG, lrun = 0.f; f32x4 o[4];
#pragma unroll
        for (int mb = 0; mb < 4; ++mb) o[mb] = (f32x4){0.f, 0.f, 0.f, 0.f};
#define DEC_BASE(j_) (((size_t)phys[PROBE ? 3 - (((j_) >> 2) & 1) : 3 - ((j_) >> 2)] * PAGE * NH + h) * HD + (size_t)(32 * ((j_) & 3) + (lane >> 4)) * (NH * HD) + 4 * (lane & 15))
#define DEC_ISSUE_K(j_, KK) do { const unsigned ob_ = (unsigned)(DEC_BASE(j_) * 4); \
        _Pragma("unroll") for (int r_ = 0; r_ < 8; ++r_) KK[r_] = __builtin_bit_cast(f32x4, __builtin_amdgcn_raw_buffer_load_b128(rsk, ob_ + (unsigned)(r_ * NH * HD * 16), 0, DEC_AUX)); } while (0)
#define DEC_ISSUE_V(j_, VV) do { const unsigned ob_ = (unsigned)(DEC_BASE(j_) * 4); \
        _Pragma("unroll") for (int r_ = 0; r_ < 8; ++r_) VV[r_] = __builtin_bit_cast(f32x4, __builtin_amdgcn_raw_buffer_load_b128(rsv, ob_ + (unsigned)(r_ * NH * HD * 16), 0, DEC_AUX)); } while (0)
#define DEC_PK4(X) pkbf_c(X[0], X[1]), pkbf_c(X[2], X[3])
#define DEC_S(j_, KK, PF, AL, ND) do { \
        _Pragma("unroll") for (int r_ = 0; r_ < 8; ++r_) *(LAS u32x2*)(kimg + iwr + 4 * r_ * DEC_VPITCH) = (u32x2){DEC_PK4(KK[r_])}; \
        if ((j_) + 2 < 16) DEC_ISSUE_K((j_) + 2, KK); \
        const LAS float* bt_ = btab + ((3 - ((j_) >> 2)) * 2 + hh) * 128 + 32 * ((j_) & 3); \
        f32x4 sA = *(const LAS f32x4*)(bt_ + 4 * g), sB = *(const LAS f32x4*)(bt_ + 16 + 4 * g); \
        _Pragma("unroll") for (int half = 0; half < 2; ++half) { \
            const bf16x8 fa = *(const LAS bf16x8*)(kimg + krd + 64 * half), fb = *(const LAS bf16x8*)(kimg + krd + 16 * DEC_VPITCH + 64 * half); \
            sA = __builtin_amdgcn_mfma_f32_16x16x32_bf16(fa, qf[half], sA, 0, 0, 0); sB = __builtin_amdgcn_mfma_f32_16x16x32_bf16(fb, qf[half], sB, 0, 0, 0); } \
        float bm = fmaxf(fmaxf(fmaxf(sA[0], sA[1]), fmaxf(sA[2], sA[3])), fmaxf(fmaxf(sB[0], sB[1]), fmaxf(sB[2], sB[3]))); \
        bm = xg_max(bm); \
        const float mnew = fmaxf(mrun, bm); AL = __builtin_amdgcn_exp2f(mrun - mnew); mrun = mnew; \
        float pa[4], pb[4], psum = 0.f; \
        _Pragma("unroll") for (int i_ = 0; i_ < 4; ++i_) { pa[i_] = __builtin_amdgcn_exp2f(sA[i_] - mnew); pb[i_] = __builtin_amdgcn_exp2f(sB[i_] - mnew); psum += pa[i_] + pb[i_]; } \
        lrun = lrun * AL + psum; \
        ND = __any((n < 8) && (psum != 0.f)) != 0;     \
        PF = (u32x4){pkbf_c(pa[0], pa[1]), pkbf_c(pa[2], pa[3]), pkbf_c(pb[0], pb[1]), pkbf_c(pb[2], pb[3])}; } while (0)
#define DEC_PV(j_, VV, PF, AL, ND, ND2) do { \
        if (ND) { _Pragma("unroll") for (int r_ = 0; r_ < 8; ++r_) *(LAS u32x2*)(vimg + iwr + 4 * r_ * DEC_VPITCH) = (u32x2){DEC_PK4(VV[r_])}; } \
        if ((j_) + 2 < 16 && (ND2)) DEC_ISSUE_V((j_) + 2, VV); \
        _Pragma("unroll") for (int mb = 0; mb < 4; ++mb) o[mb] = o[mb] * AL; \
        if (ND) { _Pragma("unroll") for (int mb = 0; mb < 4; ++mb) { \
            const v4i16_t t0 = __builtin_amdgcn_ds_read_tr16_b64_v4i16((LAS v4i16_t*)(vimg + vrd + 32 * mb)), t1 = __builtin_amdgcn_ds_read_tr16_b64_v4i16((LAS v4i16_t*)(vimg + vrd + 16 * DEC_VPITCH + 32 * mb)); \
            const bf16x8 vf = (bf16x8){t0[0], t0[1], t0[2], t0[3], t1[0], t1[1], t1[2], t1[3]}; \
            o[mb] = __builtin_amdgcn_mfma_f32_16x16x32_bf16(vf, __builtin_bit_cast(bf16x8, PF), o[mb], 0, 0, 0); } } } while (0)
        f32x4 kA[8], kB[8], vA[8], vB[8]; u32x4 pf0, pf1, pf2; float al0, al1, al2 = 1.f; bool nd0, nd1, nd2 = false;
        pf2 = (u32x4){0u, 0u, 0u, 0u};
        DEC_ISSUE_K(0, kA); DEC_ISSUE_K(1, kB);
        DEC_S(0, kA, pf0, al0, nd0); if (nd0) DEC_ISSUE_V(0, vA);
        DEC_S(1, kB, pf1, al1, nd1); if (nd1) DEC_ISSUE_V(1, vB);
        for (int j = 0; j < 16; j += 2) {
            if (j + 2 < 16) DEC_S(j + 2, kA, pf2, al2, nd2);
            DEC_PV(j, vA, pf0, al0, nd0, nd2);
            pf0 = pf2; al0 = al2; nd0 = nd2;
            if (j + 3 < 16) DEC_S(j + 3, kB, pf2, al2, nd2);
            DEC_PV(j + 1, vB, pf1, al1, nd1, nd2);
            pf1 = pf2; al1 = al2; nd1 = nd2;
        }
#undef DEC_BASE
#undef DEC_ISSUE_K
#undef DEC_ISSUE_V
#undef DEC_S
#undef DEC_PV
#undef DEC_PK4
        float l = lrun; l += __shfl_xor(l, 16); l += __shfl_xor(l, 32);
        if (!PROBE && n < 8) { const size_t rec = ((size_t)(b * NH + h) * 32 + sp) * 8 + n; float* PML = (float*)(F.ws + WS_PML); float* PO = (float*)(F.ws + WS_PO);
            if (g == 0) { PML[rec * 2] = mrun; PML[rec * 2 + 1] = l; }
#pragma unroll
            for (int mb = 0; mb < 4; ++mb) *(GAS f32x4*)(PO + rec * 64 + 16 * mb + 4 * g) = o[mb]; }
    }
}
__device__ __forceinline__ void decode_combine(Frame& F, int job) {
    const int tid_ = tid_fresh(), lane = tid_ & 63;
    const int bh = job >> 3, q = job & 7, b = bh >> 4, h = bh & 15;
    const float* PML = (const float*)(F.ws + WS_PML); const float* PO = (const float*)(F.ws + WS_PO);
    const bf16* Qb = (const bf16*)(F.ws + WS_Q); const bf16* KBb = (const bf16*)(F.ws + WS_KB); const bf16* VBb = (const bf16*)(F.ws + WS_VB);
    const size_t rec0 = (size_t)bh * 32 * 8;
    float po[32];
#pragma unroll
    for (int s = 0; s < 32; ++s) po[s] = PO[(rec0 + (size_t)s * 8 + q) * 64 + lane];
    const float pm = (lane < 32) ? PML[(rec0 + (size_t)lane * 8 + q) * 2] : NEGBIG, pl = (lane < 32) ? PML[(rec0 + (size_t)lane * 8 + q) * 2 + 1] : 0.f;
    float kd[8], vd[8], lfn[8];
#pragma unroll
    for (int i = 0; i < 8; ++i) { kd[i] = __uint_as_float((unsigned)KBb[(size_t)(MP + b * DS + i) * AW + h * HD + lane] << 16); vd[i] = __uint_as_float((unsigned)VBb[(size_t)(MP + b * DS + i) * AW + h * HD + lane] << 16);
        lfn[i] = F.out[O_LFS + (size_t)(b * DS + i) * NH + h]; }
    const float qd = __uint_as_float((unsigned)Qb[(size_t)(MP + b * DS + q) * AW + h * HD + lane] << 16);
    float xs[8], run = 0.f;
#pragma unroll
    for (int s = 0; s < 8; ++s) { run += lfn[s]; xs[s] = (s <= q) ? wave_sum(qd * kd[s]) - run * LOG2E : NEGBIG; }
    float mt = wave_max(pm);
#pragma unroll
    for (int s = 0; s < 8; ++s) mt = fmaxf(mt, xs[s]);
    const float sc = __builtin_amdgcn_exp2f(pm - mt);
    float lt = wave_sum(pl * sc), od = 0.f;
#pragma unroll
    for (int s = 0; s < 8; ++s) { const float p = (s <= q) ? __builtin_amdgcn_exp2f(xs[s] - mt) : 0.f; lt += p; od += p * vd[s]; }
#pragma unroll
    for (int s = 0; s < 32; ++s) od += __shfl(sc, s) * po[s];
    const size_t row = MP + b * DS + q; const float gate = __uint_as_float((unsigned)((const bf16*)(F.ws + WS_GA))[row * AW + h * HD + lane] << 16);
    const float r = od / lt * gate;
    ((bf16*)(F.ws + WS_AB))[row * DMODEL + 1024 + h * HD + lane] = (unsigned short)(pkbf(r, r) & 0xffffu);
}
#ifdef DIAG
__device__ __forceinline__ float diag_rinv(const float* xrow, int lane) { float ss = 0.f; for (int k = lane; k < DMODEL; k += 64) ss += xrow[k] * xrow[k]; ss = wave_sum(ss); return 1.0f / sqrtf(ss * (1.0f / DMODEL) + EPS); }
__device__ __forceinline__ float diag_proj(Frame& F, const float* xrow, int col0, int lane, int ncol) { float acc = 0.f; if (lane < ncol) for (int k = 0; k < DMODEL; ++k) acc += xrow[k] * F.norm_gain[k] * F.w_in[(size_t)k * INC + col0 + lane]; return acc; }
__device__ __forceinline__ bool diag_cmp(float ref, float got, int lane, int ncol) { float d = (lane < ncol) ? (ref - got) * (ref - got) : 0.f, r = (lane < ncol) ? ref * ref : 0.f; d = wave_sum(d); r = wave_sum(r); return !(d <= 1e-3f * r + 1e-12f); }
__device__ __forceinline__ void diag_phase(Frame& F) {
    if (blockIdx.x != 0) return;
    const int tid_ = tid_fresh(), lane = tid_ & 63, w = F.wave;
    const int rows[3] = {0, 3000, 8191}, heads[3] = {0, 9, 15}, srows[3] = {0, 37, 63};
    bool bad[8] = {false, false, false, false, false, false, false, false};
    for (int ci = w; ci < 9; ci += 8) { const int ri = ci / 3, hi = ci % 3, h = heads[hi];
        { const int row = rows[ri]; const float* xr = F.xp + (size_t)row * DMODEL; const float r = diag_rinv(xr, lane);
            float kq = diag_proj(F, xr, 3072 + 64 * h, lane, 64) * r; float ss = wave_sum(kq * kq); kq = kq / sqrtf(ss * (1.0f / 64.0f) + EPS) * F.kg[lane];
            bad[0] |= diag_cmp(kq, F.out[O_KP + (size_t)row * AW + 64 * h + lane], lane, 64);
            const float vv = diag_proj(F, xr, 4096 + 64 * h, lane, 64) * r; bad[1] |= diag_cmp(vv, F.out[O_VP + (size_t)row * AW + 64 * h + lane], lane, 64);
            float fl = diag_proj(F, xr, FLC, lane, 16) * r; fl = (lane < 16) ? logsigmoidf_(fl + F.b_f[lane & 15]) : 0.f; bad[2] |= diag_cmp(fl, (lane < 16) ? F.out[O_LFP + (size_t)row * NH + lane] : 0.f, lane, 16);
            const int b = ri, j = 3 + 4 * hi, prow = b * SEQ + (SEQ - PBUF) + j; const float* xq = F.xp + (size_t)prow * DMODEL; const float r2 = diag_rinv(xq, lane);
            const float uu = diag_proj(F, xq, 64 * h, lane, 64) * r2; bad[3] |= diag_cmp(uu, F.out[O_PP + ((size_t)b * PBUF + j) * PW + 64 * h + lane], lane, 64); }
        { const int sr = srows[ri]; const float* xr = F.xs + (size_t)sr * DMODEL; const float r = diag_rinv(xr, lane);
            float kq = diag_proj(F, xr, 3072 + 64 * h, lane, 64) * r; float ss = wave_sum(kq * kq); kq = kq / sqrtf(ss * (1.0f / 64.0f) + EPS) * F.kg[lane];
            bad[4] |= diag_cmp(kq, F.out[O_KS + (size_t)sr * AW + 64 * h + lane], lane, 64);
            const float vv = diag_proj(F, xr, 4096 + 64 * h, lane, 64) * r; bad[5] |= diag_cmp(vv, F.out[O_VS + (size_t)sr * AW + 64 * h + lane], lane, 64);
            float fl = diag_proj(F, xr, FLC, lane, 16) * r; fl = (lane < 16) ? logsigmoidf_(fl + F.b_f[lane & 15]) : 0.f; bad[6] |= diag_cmp(fl, (lane < 16) ? F.out[O_LFS + (size_t)sr * NH + lane] : 0.f, lane, 16);
            const int b = sr >> 3, i = sr & 7; const float uu = diag_proj(F, xr, 64 * h, lane, 64) * r; bad[4] |= diag_cmp(uu, F.out[O_PS + ((size_t)b * PBUF + 7 + i) * PW + 64 * h + lane], lane, 64);
            const int r7 = hi * 3; bad[7] |= diag_cmp(F.state_pool[((size_t)b * PBUF + 8 + r7) * PW + 64 * h + lane], F.out[O_PS + ((size_t)b * PBUF + r7) * PW + 64 * h + lane], lane, 64); } }
    LAS unsigned* acc = (LAS unsigned*)(F.lds + 1024);
    if (tid_ == 0) *acc = 0u;
    __syncthreads();
    unsigned m = (bad[0] ? 1u : 0u) | (bad[1] ? 2u : 0u) | (bad[2] ? 4u : 0u) | (bad[3] ? 8u : 0u) | ((bad[4] || bad[5]) ? 16u : 0u) | ((bad[6] || bad[7]) ? 32u : 0u);
    if (lane == 0) atomicOr((unsigned*)acc, m);
    __syncthreads();
    if (tid_ == 0) F.out[O_YP] = 1.0e4f * (float)(1u + *acc);
}
#endif
#ifndef REP0
#define REP0 1
#define REP1 1
#define REP2 1
#define REP3 1
#define REP4 1
#define REP5 1
#define REP6 1
#endif
#ifndef SREP4
#define SREP4 1
#endif
#ifndef SREP5
#define SREP5 1
#endif
#ifndef SREP2
#define SREP2 1
#endif
#ifndef SREP3
#define SREP3 1
#endif
#ifndef SREP
#define SREP 1
#endif

__device__ __forceinline__ void phase_p1(Frame& F, const int bx, unsigned char* lds) {
    const bool qcu = (bx >= 32 && bx < 48), fused = (F.G == 256);
    for (int r_ = 0; r_ < SREP4; ++r_) if (fused || (F.G > LATE_CU0 && bx >= LATE_CU0)) p0_late_items(F, bx);
    if (!fused) { for (int su = bx; su < NIN / 64; su += F.G) sample_in_unit(F, su);
        if (qcu) q_publish(F); }
#ifndef KS_MODE
#define KS_MODE 6
#endif
    const int ksplit = (fused && KS_MODE == 6) ? ((bx >> 3) % 6) : (fused && KS_MODE == 5) ? ((bx >> 3) % 5) : ((bx >> 3) & 3) + 1;
    EpiIn E{((float*)(F.ws + WS_RINV)), ((bf16*)(F.ws + WS_U)), ((bf16*)(F.ws + WS_GP)), ((bf16*)(F.ws + WS_Q)), ((bf16*)(F.ws + WS_KB)), ((bf16*)(F.ws + WS_VB)), ((bf16*)(F.ws + WS_GA)), (unsigned char*)(F.ws + WS_MA8), (unsigned char*)(F.ws + WS_MB8), F.out + O_KP, F.out + O_VP, F.out + O_PP, F.qg, F.kg};
    const pg8::Gemm g{DMODEL, DMODEL, DMODEL};
    { SchedIn S{F.G, bx, 0, ksplit, (const char*)((bf16*)(F.ws + WS_XB)), (const char*)((bf16*)(F.ws + WS_WIN))};
      pg8::gemm_phase<EpiIn, SchedIn, true, true>(F.lds + RING_OFF, g, S, E); }
    __syncthreads();
    if (!fused) q_wait(F);
    decode_partials(F); __syncthreads();
    if (REP2 == 2) { decode_partials(F); __syncthreads(); }
    if (REP2 == 3) { decode_partials<true>(F); __syncthreads(); }
    { SchedIn S{F.G, bx, ksplit, 5, (const char*)((bf16*)(F.ws + WS_XB)), (const char*)((bf16*)(F.ws + WS_WIN))};
      pg8::gemm_phase<EpiIn, SchedIn, true, true>(F.lds + RING_OFF, g, S, E); }
    __syncthreads();
}
__device__ __forceinline__ void phase_p2b(Frame& F, const int bx, unsigned char* lds) {
        const attn_body::AttnTensors AT{(const attn_body::bf16*)((bf16*)(F.ws + WS_Q)), (const attn_body::bf16*)((bf16*)(F.ws + WS_KB)), (const attn_body::bf16*)((bf16*)(F.ws + WS_VB)), (const attn_body::bf16*)((bf16*)(F.ws + WS_GA)), (attn_body::bf16*)(((bf16*)(F.ws + WS_AB)) + 1024), F.out + O_LFP};
        for (int r_ = 0; r_ < SREP2; ++r_) if ((bx & 7) >= 4 && bx < 32) sample_pool_unit(F, (bx >> 3) * 4 + (bx & 3));
        for (int r_ = 0; r_ < SREP3; ++r_) { const int job = F.vcu * NWAVES + F.wave; if (job < DB * NH * DS) decode_combine(F, job); }
        __syncthreads();
        const attn_body::StaticOrder S((int)F.G, bx);
#ifndef NO_ATT
        attn_body::attn_phase<attn_body::StaticOrder>((char*)lds + RING_OFF, AT, S);
#endif
        if (REP3 > 1) { __syncthreads(); attn_body::attn_phase<attn_body::StaticOrder>((char*)lds + RING_OFF, AT, S); }
        __syncthreads();
        for (int unit = bx; unit < 256; unit += F.G) pool_unit_lds(F, unit);
}
__device__ __forceinline__ void phase_p3(Frame& F, const int bx, unsigned char* lds) {
        pg8::Gemm g{DMODEL, DMODEL, DMODEL}; SchedUp S{F.G, bx, (const char*)((bf16*)(F.ws + WS_AB)), (const char*)((bf16*)(F.ws + WS_WUP))};
        EpiUp E{(const unsigned char*)(F.ws + WS_MA8), (const unsigned char*)(F.ws + WS_MB8), ((bf16*)(F.ws + WS_MG))};
        for (int r_ = 0; r_ < SREP; ++r_) for (int j = bx; j < 256; j += F.G) sample_up_sub(F, j);
        pg8::gemm_phase<EpiUp, SchedUp, true, true>(F.lds + RING_OFF, g, S, E);
}
__device__ __forceinline__ void phase_p4(Frame& F, const int bx, unsigned char* lds) {
        pg8::Gemm g{DMODEL, DMODEL, DMODEL}; SchedOut S{F.G, bx, (const char*)((bf16*)(F.ws + WS_MG)), (const char*)((bf16*)(F.ws + WS_WOUT))};
        EpiOut E{F.xp, F.out + O_YP};
        for (int r_ = 0; r_ < SREP; ++r_) for (int j = bx; j < 256; j += F.G) sample_out_sub(F, j);
        pg8::gemm_phase<EpiOut, SchedOut, true, true>(F.lds + RING_OFF, g, S, E);
}

__global__ void __launch_bounds__(NWAVES * 64, 2) mega_fwd(Args args) {
    extern __shared__ __attribute__((aligned(16))) unsigned char lds[];
    Frame F;
    F.lds = (LAS unsigned char*)lds;
    F.MISC = (volatile LAS unsigned*)(F.lds + MISC_OFF);
    F.wave = __builtin_amdgcn_readfirstlane((int)threadIdx.x >> 6);
    F.G = gridDim.x; { const int bx = blockIdx.x; F.vcu = (F.G % 8 == 0) ? (bx % 8) * (F.G / 8) + bx / 8 : bx; }
    unsigned char* ws = args.ws;
    F.ctl = (gu32*)(ws + WS_CTL);
    F.xp = args.in[0]; F.xs = args.in[1]; F.cache_k = args.in[2]; F.cache_v = args.in[3]; F.cache_lf = args.in[4]; F.state_pool = args.in[5]; F.page_table = (const int*)args.in[6];
    F.norm_gain = args.in[7]; F.w_in = args.in[8]; F.b_f = args.in[9]; F.qg = args.in[10]; F.kg = args.in[11]; F.w_pm = args.in[12]; F.pool_scale = args.in[13];
    F.w_upp = args.in[14]; F.w_upa = args.in[15]; F.w_out = args.in[16]; F.out = args.out;
    F.ws = ws;
    for (int u = threadIdx.x; u < (LDS_BYTES - LDSCTL_OFF) / 4; u += NWAVES * 64) ((LAS unsigned*)(F.lds + LDSCTL_OFF))[u] = 0u;
    __syncthreads();
    XcdBarrier bar = xcd_barrier_post((unsigned*)(F.ctl + CW_BAR), F.MISC + 8);
    const int bx = (int)blockIdx.x;
    p0_prologue(F); xcd_barrier(bar);
    if (REP0 > 1) { p0_prologue(F); xcd_barrier(bar); }
    phase_p1(F, bx, lds); xcd_barrier(bar);
    if (REP1 > 1) { phase_p1(F, bx, lds); xcd_barrier(bar); }
    phase_p2b(F, bx, lds); xcd_barrier(bar);
    if (REP4 > 1) { phase_p2b(F, bx, lds); xcd_barrier(bar); }
    phase_p3(F, bx, lds); xcd_barrier(bar);
    if (REP5 > 1) { phase_p3(F, bx, lds); xcd_barrier(bar); }
    if (REP6 > 1) { phase_p4(F, bx, lds); xcd_barrier(bar); }
    phase_p4(F, bx, lds);
#ifdef DIAG
    xcd_barrier(bar);
    diag_phase(F);
#endif
}

extern "C" void kernel_launch(void* const* d_in, const int* in_sizes, int n_in, void* d_out, int out_size, void* d_ws, size_t ws_size, hipStream_t stream) {
    static int grid = 0;
    if (grid == 0) {
        if (n_in != 17 || (size_t)out_size != O_END || ws_size < WS_END) { fprintf(stderr, "kernel_launch: unexpected shapes (n_in %d, out %d, ws %zu); nothing launched\n", n_in, out_size, ws_size); grid = -1; return; }
        int dev = 0, cus = 0, per_cu = 0;
        if (hipGetDevice(&dev) != hipSuccess || hipDeviceGetAttribute(&cus, hipDeviceAttributeMultiprocessorCount, dev) != hipSuccess) { grid = -1; return; }
        if (hipFuncSetAttribute((const void*)mega_fwd, hipFuncAttributeMaxDynamicSharedMemorySize, LDS_BYTES) != hipSuccess) { fprintf(stderr, "kernel_launch: hipFuncSetAttribute failed\n"); grid = -1; return; }
        if (hipOccupancyMaxActiveBlocksPerMultiprocessor(&per_cu, (const void*)mega_fwd, NWAVES * 64, LDS_BYTES) != hipSuccess || per_cu < 1) fprintf(stderr, "kernel_launch: occupancy query reports %d\n", per_cu);
        (void)hipGetLastError();
        grid = cus;
        if (grid != 256) fprintf(stderr, "kernel_launch: %d CUs; the work split assumes 256\n", grid);
    }
    if (grid < 0) return;
    if (hipMemsetAsync((char*)d_ws + WS_CTL, 0, CTL_ZERO_BYTES, stream) != hipSuccess) return;
    Args a{};
    for (int i = 0; i < 17; ++i) a.in[i] = (const float*)d_in[i];
    a.out = (float*)d_out; a.ws = (unsigned char*)d_ws;
    hipLaunchKernelGGL(mega_fwd, dim3(grid), dim3(NWAVES * 64), LDS_BYTES, stream, a);
}
```
